# Optimizing an MI355X kernel written in HIP

```python
import jax
import jax.numpy as jnp
from jax import lax
import numpy as np


D_MODEL = 2048
BATCH = 1
SEQ = 8192
DEPTH = 2

N_MIXERS = 2
GRID_W = 64
PLE_DIM = 256
NORM_EPS = 1e-6
D_FF = 4 * D_MODEL

GLA_HEADS = 4
GLA_DK = D_MODEL // 2
GLA_DV = D_MODEL
GLA_HEAD_K = GLA_DK // GLA_HEADS
GLA_HEAD_V = GLA_DV // GLA_HEADS
GLA_GATE_RANK = 16
GLA_GATE_TAU = 16.0
GLA_CHUNK = 64
GLA_IN = 2 * GLA_DK + 2 * GLA_DV + 2 * GLA_GATE_RANK

ATTN_HEAD_DIM = 128
ATTN_Q_HEADS = D_MODEL // ATTN_HEAD_DIM
ATTN_KV_HEADS = 4
ATTN_GROUP = ATTN_Q_HEADS // ATTN_KV_HEADS
ATTN_Q_BLOCK = 128
ATTN_IN = (ATTN_Q_HEADS + 2 * ATTN_KV_HEADS) * ATTN_HEAD_DIM
ROPE_THETA = 10000.0
ROPE_AXIS_DIM = ATTN_HEAD_DIM // 2

kernel_name = 'hybrid_gla_axialgqa_encoder'


def rms_norm(x, gain):
    xf = x.astype(jnp.float32)
    y = xf * lax.rsqrt(jnp.mean(xf * xf, axis=-1, keepdims=True) + NORM_EPS)
    return (y * gain.astype(jnp.float32)).astype(x.dtype)


def gla_chunked(q, k, v, log_a, strict):
    bsz, nh, L, dk = q.shape
    dv = v.shape[-1]
    c = GLA_CHUNK
    n = L // c
    q = q.reshape(bsz, nh, n, c, dk)
    k = k.reshape(bsz, nh, n, c, dk)
    v = v.reshape(bsz, nh, n, c, dv)
    cum = jnp.cumsum(log_a.reshape(bsz, nh, n, c, dk), axis=3)
    last = cum[:, :, :, -1:, :]
    ref = cum[:, :, :, c // 2 - 1:c // 2, :]
    scores = jnp.einsum('bhntd,bhnsd->bhnts', q * jnp.exp(cum - ref), k * jnp.exp(ref - cum))
    mask = jnp.tril(jnp.ones((c, c), dtype=bool), k=-1 if strict else 0)
    o_intra = jnp.einsum('bhnts,bhnse->bhnte', jnp.where(mask, scores, 0.0), v)

    q_dec = q * jnp.exp(cum)
    k_to_end = k * jnp.exp(last - cum)
    chunk_decay = jnp.exp(last[:, :, :, 0, :])

    def step(state, xs):
        qd, kt, vc, dl = xs
        o = jnp.einsum('bhtd,bhde->bhte', qd, state)
        state = dl[..., None] * state + jnp.einsum('bhsd,bhse->bhde', kt, vc)
        return state, o

    xs = (jnp.moveaxis(q_dec, 2, 0), jnp.moveaxis(k_to_end, 2, 0),
          jnp.moveaxis(v, 2, 0), jnp.moveaxis(chunk_decay, 2, 0))
    state0 = jnp.zeros((bsz, nh, dk, dv), jnp.float32)
    _, o_inter = lax.scan(step, state0, xs)
    o = o_intra + jnp.moveaxis(o_inter, 0, 2)
    return o.reshape(bsz, nh, L, dv)


def gla_mixer(u, w_in, w_gk_f, b_gk_f, w_gk_b, b_gk_b, g_head, w_out):
    bsz, L, _ = u.shape
    proj = (u @ w_in).astype(jnp.float32)
    o1 = GLA_DK
    o2 = 2 * GLA_DK
    o3 = o2 + GLA_DV
    o4 = o3 + GLA_DV
    o5 = o4 + GLA_GATE_RANK
    q, k, v, og, lr_f, lr_b = jnp.split(proj, [o1, o2, o3, o4, o5], axis=-1)

    def heads(t, d):
        return t.reshape(bsz, L, GLA_HEADS, d).transpose(0, 2, 1, 3)

    q = heads(q, GLA_HEAD_K) * (GLA_HEAD_K ** -0.5)
    k = heads(k, GLA_HEAD_K)
    v = heads(v, GLA_HEAD_V)
    la_f = heads(jax.nn.log_sigmoid(lr_f @ w_gk_f.astype(jnp.float32) + b_gk_f.astype(jnp.float32)), GLA_HEAD_K) / GLA_GATE_TAU
    la_b = heads(jax.nn.log_sigmoid(lr_b @ w_gk_b.astype(jnp.float32) + b_gk_b.astype(jnp.float32)), GLA_HEAD_K) / GLA_GATE_TAU

    o_f = gla_chunked(q, k, v, la_f, strict=False)
    rev = lambda t: jnp.flip(t, axis=2)
    o_b = rev(gla_chunked(rev(q), rev(k), rev(v), rev(la_b), strict=True))
    o = rms_norm(o_f + o_b, g_head)
    o = o.transpose(0, 2, 1, 3).reshape(bsz, L, GLA_DV)
    o = o * jax.nn.silu(og)
    return o.astype(u.dtype) @ w_out


def axial_rope_tables(L):
    rows = L // GRID_W
    t_row = jnp.repeat(jnp.arange(rows, dtype=jnp.int32), GRID_W).astype(jnp.float32)
    t_col = jnp.tile(jnp.arange(GRID_W, dtype=jnp.int32), rows).astype(jnp.float32)
    inv_freq = 1.0 / (ROPE_THETA ** (jnp.arange(0, ROPE_AXIS_DIM, 2, dtype=jnp.float32) / ROPE_AXIS_DIM))
    ang = jnp.stack([t_row[:, None] * inv_freq, t_col[:, None] * inv_freq], axis=1)
    return jnp.cos(ang), jnp.sin(ang)


def apply_axial_rope(x, cos, sin):
    xr = x.astype(jnp.float32).reshape(*x.shape[:-1], 2, 2, ROPE_AXIS_DIM // 2)
    x1 = xr[..., 0, :]
    x2 = xr[..., 1, :]
    out = jnp.stack([x1 * cos - x2 * sin, x2 * cos + x1 * sin], axis=-2)
    return out.reshape(x.shape).astype(x.dtype)


def gqa_mixer(u, w_in, g_q, g_k, w_out):
    bsz, L, _ = u.shape
    hd = ATTN_HEAD_DIM
    proj = u @ w_in
    q, k, v = jnp.split(proj, [ATTN_Q_HEADS * hd, (ATTN_Q_HEADS + ATTN_KV_HEADS) * hd], axis=-1)
    q = q.reshape(bsz, L, ATTN_Q_HEADS, hd).transpose(0, 2, 1, 3)
    k = k.reshape(bsz, L, ATTN_KV_HEADS, hd).transpose(0, 2, 1, 3)
    v = v.reshape(bsz, L, ATTN_KV_HEADS, hd).transpose(0, 2, 1, 3)
    cos, sin = axial_rope_tables(L)
    q = apply_axial_rope(rms_norm(q, g_q), cos, sin)
    k = apply_axial_rope(rms_norm(k, g_k), cos, sin)
    nblk = L // ATTN_Q_BLOCK
    qb = q.reshape(bsz, ATTN_KV_HEADS, ATTN_GROUP, nblk, ATTN_Q_BLOCK, hd)
    qb = jnp.moveaxis(qb, 3, 0)
    scale = hd ** -0.5

    def attend(q_blk):
        s = jnp.einsum('bkgqd,bksd->bkgqs', q_blk, k).astype(jnp.float32) * scale
        pr = jax.nn.softmax(s, axis=-1)
        return jnp.einsum('bkgqs,bksd->bkgqd', pr.astype(v.dtype), v)

    o = lax.map(attend, qb)
    o = o.transpose(1, 4, 0, 2, 3, 5)
    o = o.reshape(bsz, L, ATTN_Q_HEADS * hd)
    return o @ w_out


def squared_relu_mlp(u, w_up, w_down):
    hid = jax.nn.relu(u @ w_up)
    return (hid * hid) @ w_down


def setup_inputs(seed: int = 0) -> dict:
    key = jax.random.key(seed)
    ks = jax.random.split(key, 22)
    n_a = (DEPTH + N_MIXERS - 1) // N_MIXERS
    n_b = DEPTH // N_MIXERS

    def nrm(k, shape, scale):
        return scale * jax.random.normal(k, shape, jnp.float32)

    def gain(k, shape):
        return 1.0 + nrm(k, shape, 0.05)

    return {
        'x': nrm(ks[0], (BATCH, SEQ, D_MODEL), 1.0),
        'p': nrm(ks[1], (DEPTH, BATCH, SEQ, PLE_DIM), 1.0),
        'g_pre_mix': gain(ks[2], (DEPTH, D_MODEL)),
        'g_post_mix': gain(ks[3], (DEPTH, D_MODEL)),
        'g_pre_mlp': gain(ks[4], (DEPTH, D_MODEL)),
        'g_post_mlp': gain(ks[5], (DEPTH, D_MODEL)),
        'g_ple': gain(ks[6], (DEPTH, D_MODEL)),
        'w_mlp_up': nrm(ks[7], (DEPTH, D_MODEL, D_FF), D_MODEL ** -0.5),
        'w_mlp_down': nrm(ks[8], (DEPTH, D_FF, D_MODEL), D_FF ** -0.5),
        'w_ple_proj': nrm(ks[9], (DEPTH, PLE_DIM, D_MODEL), PLE_DIM ** -0.5),
        'w_ple_gate': nrm(ks[10], (DEPTH, D_MODEL, D_MODEL), D_MODEL ** -0.5),
        'gla_w_in': nrm(ks[11], (n_a, D_MODEL, GLA_IN), D_MODEL ** -0.5),
        'gla_w_gk_fwd': nrm(ks[12], (n_a, GLA_GATE_RANK, GLA_DK), GLA_GATE_RANK ** -0.5),
        'gla_b_gk_fwd': nrm(ks[13], (n_a, GLA_DK), 0.1),
        'gla_w_gk_bwd': nrm(ks[14], (n_a, GLA_GATE_RANK, GLA_DK), GLA_GATE_RANK ** -0.5),
        'gla_b_gk_bwd': nrm(ks[15], (n_a, GLA_DK), 0.1),
        'gla_g_head': gain(ks[16], (n_a, GLA_HEAD_V)),
        'gla_w_out': nrm(ks[17], (n_a, GLA_DV, D_MODEL), GLA_DV ** -0.5),
        'attn_w_in': nrm(ks[18], (n_b, D_MODEL, ATTN_IN), D_MODEL ** -0.5),
        'attn_g_q': gain(ks[19], (n_b, ATTN_HEAD_DIM)),
        'attn_g_k': gain(ks[20], (n_b, ATTN_HEAD_DIM)),
        'attn_w_out': nrm(ks[21], (n_b, ATTN_Q_HEADS * ATTN_HEAD_DIM, D_MODEL), D_MODEL ** -0.5),
    }


def reference(x, p, g_pre_mix, g_post_mix, g_pre_mlp, g_post_mlp, g_ple, w_mlp_up, w_mlp_down,
              w_ple_proj, w_ple_gate, gla_w_in, gla_w_gk_fwd, gla_b_gk_fwd, gla_w_gk_bwd,
              gla_b_gk_bwd, gla_g_head, gla_w_out, attn_w_in, attn_g_q, attn_g_k, attn_w_out):
    h = x
    for i in range(DEPTH):
        j = i // N_MIXERS
        u = rms_norm(h, g_pre_mix[i])
        if i % N_MIXERS == 0:
            mix = gla_mixer(u, gla_w_in[j], gla_w_gk_fwd[j], gla_b_gk_fwd[j], gla_w_gk_bwd[j],
                            gla_b_gk_bwd[j], gla_g_head[j], gla_w_out[j])
        else:
            mix = gqa_mixer(u, attn_w_in[j], attn_g_q[j], attn_g_k[j], attn_w_out[j])
        h = h + rms_norm(mix, g_post_mix[i])
        m = squared_relu_mlp(rms_norm(h, g_pre_mlp[i]), w_mlp_up[i], w_mlp_down[i])
        h = h + rms_norm(m, g_post_mlp[i])
        gate = jax.nn.sigmoid((h @ w_ple_gate[i]).astype(jnp.float32)).astype(h.dtype)
        e = p[i] @ w_ple_proj[i]
        h = h + rms_norm(gate * e, g_ple[i])
    return h
```

```cpp
#include <hip/hip_runtime.h>
#include <hip/hip_bf16.h>
#include <cstdio>
#include <cstdint>
#include <cmath>
namespace nv {
constexpr int L = 8192, DM = 2048, DFF = 8192, PLE = 256;
constexpr int GIN = 6176, AIN = 3072;
constexpr float EPS = 1e-6f;

__device__ __forceinline__ float block_sum_256(float v, float* red) {
  for (int o = 32; o > 0; o >>= 1) v += __shfl_xor(v, o);
  __syncthreads();
  if ((threadIdx.x & 63) == 0) red[threadIdx.x >> 6] = v;
  __syncthreads();
  return red[0] + red[1] + red[2] + red[3];
}
__global__ __launch_bounds__(256) void k_rmsnorm(const float* __restrict__ in, const float* __restrict__ gain, float* __restrict__ out) {
  __shared__ float red[4];
  const float* r = in + (size_t)blockIdx.x * DM; float v[8]; float s = 0.f;
#pragma unroll
  for (int i = 0; i < 8; ++i) { v[i] = r[threadIdx.x + 256 * i]; s += v[i] * v[i]; }
  s = block_sum_256(s, red); const float rs = rsqrtf(s / DM + EPS);
#pragma unroll
  for (int i = 0; i < 8; ++i) out[(size_t)blockIdx.x * DM + threadIdx.x + 256 * i] = v[i] * rs * gain[threadIdx.x + 256 * i];
}
__global__ __launch_bounds__(256) void k_add_rmsnorm(const float* __restrict__ hin, const float* __restrict__ t, const float* __restrict__ gain, float* __restrict__ hout) {
  __shared__ float red[4];
  const float* r = t + (size_t)blockIdx.x * DM; float v[8]; float s = 0.f;
#pragma unroll
  for (int i = 0; i < 8; ++i) { v[i] = r[threadIdx.x + 256 * i]; s += v[i] * v[i]; }
  s = block_sum_256(s, red); const float rs = rsqrtf(s / DM + EPS);
#pragma unroll
  for (int i = 0; i < 8; ++i) { const size_t o = (size_t)blockIdx.x * DM + threadIdx.x + 256 * i; hout[o] = hin[o] + v[i] * rs * gain[threadIdx.x + 256 * i]; }
}
template <int EPI>
__global__ __launch_bounds__(256) void k_sgemm(const float* __restrict__ A, int lda, const float* __restrict__ B, int ldb, float* __restrict__ C, int ldc, int M, int N, int K) {
  __shared__ float As[16][68];
  __shared__ float Bs[16][68];
  const int bm = blockIdx.y * 64, bn = blockIdx.x * 64, tid = threadIdx.x, tx = tid & 15, ty = tid >> 4;
  float acc[4][4];
#pragma unroll
  for (int i = 0; i < 4; ++i)
#pragma unroll
    for (int j = 0; j < 4; ++j) acc[i][j] = 0.f;
  const int ar = tid >> 2, ak = (tid & 3) * 4, bk = tid >> 4, bn4 = (tid & 15) * 4;
  for (int k0 = 0; k0 < K; k0 += 16) {
    const float4 a4 = *(const float4*)(A + (size_t)(bm + ar) * lda + k0 + ak);
    As[ak + 0][ar] = a4.x; As[ak + 1][ar] = a4.y; As[ak + 2][ar] = a4.z; As[ak + 3][ar] = a4.w;
#pragma unroll
    for (int i = 0; i < 4; ++i) { const int c = bn + bn4 + i; Bs[bk][bn4 + i] = (c < N) ? B[(size_t)(k0 + bk) * ldb + c] : 0.f; }
    __syncthreads();
#pragma unroll
    for (int k = 0; k < 16; ++k) {
      float a[4], b[4];
#pragma unroll
      for (int i = 0; i < 4; ++i) { a[i] = As[k][ty * 4 + i]; b[i] = Bs[k][tx * 4 + i]; }
#pragma unroll
      for (int i = 0; i < 4; ++i)
#pragma unroll
        for (int j = 0; j < 4; ++j) acc[i][j] = fmaf(a[i], b[j], acc[i][j]);
    }
    __syncthreads();
  }
#pragma unroll
  for (int i = 0; i < 4; ++i)
#pragma unroll
    for (int j = 0; j < 4; ++j) { const int c = bn + tx * 4 + j; if (c < N) { float v = acc[i][j]; if (EPI == 1) { v = v > 0.f ? v : 0.f; v = v * v; } C[(size_t)(bm + ty * 4 + i) * ldc + c] = v; } }
}
__device__ __forceinline__ float logsigmoidf(float z) { return fminf(z, 0.f) - log1pf(expf(-fabsf(z))); }
__global__ __launch_bounds__(256) void k_gla_scan(const float* __restrict__ proj, const float* __restrict__ wgk, const float* __restrict__ bgk, float* __restrict__ o, int dir) {
  const int h = blockIdx.y, e0 = blockIdx.x * 16, tid = threadIdx.x, e = tid & 15, dg = tid >> 4;
  __shared__ float qs[256], ks[256], as[256], vs[16], red[16][17], kprev[256], vprev[16];
  float S[16];
#pragma unroll
  for (int i = 0; i < 16; ++i) S[i] = 0.f;
  float wcol[16];
#pragma unroll
  for (int r = 0; r < 16; ++r) wcol[r] = wgk[r * 1024 + h * 256 + tid];
  const float bb = bgk[h * 256 + tid];
  const int lroff = dir == 0 ? 6144 : 6160;
  kprev[tid] = 0.f; if (tid < 16) vprev[tid] = 0.f;
  for (int step = 0; step < L; ++step) {
    const int t = dir == 0 ? step : L - 1 - step;
    const float* row = proj + (size_t)t * GIN;
    float z = bb;
#pragma unroll
    for (int r = 0; r < 16; ++r) z = fmaf(row[lroff + r], wcol[r], z);
    const float la = logsigmoidf(z) * (1.f / 16.f);
    const float kreg = row[1024 + h * 256 + tid];
    float vreg = 0.f; if (tid < 16) vreg = row[2048 + h * 512 + e0 + tid];
    as[tid] = expf(la); qs[tid] = row[h * 256 + tid] * 0.0625f; ks[tid] = kreg; if (tid < 16) vs[tid] = vreg;
    __syncthreads();
    float part = 0.f;
    if (dir == 0) {
#pragma unroll
      for (int i = 0; i < 16; ++i) { const int d = dg * 16 + i; S[i] = fmaf(as[d], S[i], ks[d] * vs[e]); part = fmaf(qs[d], S[i], part); }
    } else {
#pragma unroll
      for (int i = 0; i < 16; ++i) { const int d = dg * 16 + i; S[i] = as[d] * (S[i] + kprev[d] * vprev[e]); part = fmaf(qs[d], S[i], part); }
    }
    red[dg][e] = part;
    __syncthreads();
    if (tid < 16) { float s = 0.f;
#pragma unroll
      for (int g = 0; g < 16; ++g) s += red[g][tid];
      float* op = o + (size_t)t * DM + h * 512 + e0 + tid; if (dir == 0) *op = s; else *op += s; }
    kprev[tid] = kreg; if (tid < 16) vprev[tid] = vreg;
  }
}
__global__ __launch_bounds__(256) void k_gla_gate(float* __restrict__ o, const float* __restrict__ proj, const float* __restrict__ ghead) {
  __shared__ float red[4];
  const int t = blockIdx.x;
  for (int h = 0; h < 4; ++h) {
    float* r = o + (size_t)t * DM + h * 512; const float v0 = r[threadIdx.x], v1 = r[threadIdx.x + 256];
    const float s = block_sum_256(v0 * v0 + v1 * v1, red); const float rs = rsqrtf(s / 512.f + EPS);
    const float g0 = proj[(size_t)t * GIN + 4096 + h * 512 + threadIdx.x], g1 = proj[(size_t)t * GIN + 4096 + h * 512 + threadIdx.x + 256];
    r[threadIdx.x] = v0 * rs * ghead[threadIdx.x] * (g0 / (1.f + expf(-g0)));
    r[threadIdx.x + 256] = v1 * rs * ghead[threadIdx.x + 256] * (g1 / (1.f + expf(-g1)));
    __syncthreads();
  }
}
__global__ __launch_bounds__(128) void k_qk_norm_rope(float* __restrict__ proj, const float* __restrict__ gq, const float* __restrict__ gk) {
  __shared__ float y[128]; __shared__ float red[2];
  const int t = blockIdx.x, hh = blockIdx.y, i = threadIdx.x;
  float* p = proj + (size_t)t * AIN + hh * 128; const float* g = hh < 16 ? gq : gk;
  const float v = p[i]; float s = v * v;
  for (int o = 32; o > 0; o >>= 1) s += __shfl_xor(s, o);
  if ((i & 63) == 0) red[i >> 6] = s;
  __syncthreads();
  const float rs = rsqrtf((red[0] + red[1]) / 128.f + EPS);
  y[i] = v * rs * g[i];
  __syncthreads();
  const int a = i >> 6, w = i & 63, b = w >> 5, j = w & 31;
  const float pos = (float)(a == 0 ? (t / 64) : (t % 64));
  const float invf = 1.0f / powf(10000.0f, (float)(2 * j) / 64.0f);
  const float ang = pos * invf, c = cosf(ang), sn = sinf(ang);
  const float out = b == 0 ? (y[i] * c - y[i + 32] * sn) : (y[i] * c + y[i - 32] * sn);
  p[i] = out;
}
__global__ __launch_bounds__(128) void k_attn(const float* __restrict__ proj, float* __restrict__ o) {
  __shared__ float Ks[32][132]; __shared__ float Vs[32][132];
  const int h = blockIdx.y, kvh = h >> 2, tid = threadIdx.x, r = tid >> 2, p = tid & 3, t = blockIdx.x * 32 + r;
  float q[32], acc[32];
#pragma unroll
  for (int i = 0; i < 32; ++i) { q[i] = proj[(size_t)t * AIN + h * 128 + p * 32 + i] * 0.08838834764831845f; acc[i] = 0.f; }
  float m = -1e30f, l = 0.f;
  for (int k0 = 0; k0 < L; k0 += 32) {
    __syncthreads();
#pragma unroll
    for (int i = 0; i < 32; ++i) { const int idx = i * 128 + tid, rr = idx >> 7, cc = idx & 127;
      Ks[rr][(cc >> 5) * 33 + (cc & 31)] = proj[(size_t)(k0 + rr) * AIN + 2048 + kvh * 128 + cc];
      Vs[rr][(cc >> 5) * 33 + (cc & 31)] = proj[(size_t)(k0 + rr) * AIN + 2560 + kvh * 128 + cc]; }
    __syncthreads();
    float s[32]; float tm = -1e30f;
#pragma unroll
    for (int j = 0; j < 32; ++j) { float d = 0.f;
#pragma unroll
      for (int i = 0; i < 32; ++i) d = fmaf(q[i], Ks[j][p * 33 + i], d);
      d += __shfl_xor(d, 1); d += __shfl_xor(d, 2); s[j] = d; tm = fmaxf(tm, d); }
    const float mn = fmaxf(m, tm), corr = expf(m - mn); l *= corr;
#pragma unroll
    for (int i = 0; i < 32; ++i) acc[i] *= corr;
#pragma unroll
    for (int j = 0; j < 32; ++j) { const float pj = expf(s[j] - mn); l += pj;
#pragma unroll
      for (int i = 0; i < 32; ++i) acc[i] = fmaf(pj, Vs[j][p * 33 + i], acc[i]); }
    m = mn;
  }
  const float il = 1.f / l;
  const int orow = (t & 127) * 64 + (t >> 7);
#pragma unroll
  for (int i = 0; i < 32; ++i) o[(size_t)orow * DM + h * 128 + p * 32 + i] = acc[i] * il;
}
__global__ __launch_bounds__(256) void k_ple_mul(float* __restrict__ gate, const float* __restrict__ e, size_t n) {
  const size_t i = (size_t)blockIdx.x * 256 + threadIdx.x; if (i < n) gate[i] = e[i] / (1.f + expf(-gate[i]));
}

struct In {
  const float *x, *p, *g_pre_mix, *g_post_mix, *g_pre_mlp, *g_post_mlp, *g_ple, *w_up, *w_down, *w_ple_proj, *w_ple_gate,
      *gla_w_in, *gla_wgk_f, *gla_bgk_f, *gla_wgk_b, *gla_bgk_b, *gla_g_head, *gla_w_out, *attn_w_in, *attn_gq, *attn_gk, *attn_w_out;
};
inline void sgemm(hipStream_t st, int epi, const float* A, int lda, const float* B, int ldb, float* C, int ldc, int M, int N, int K) {
  dim3 g((N + 63) / 64, M / 64);
  if (epi == 0) hipLaunchKernelGGL(k_sgemm<0>, g, dim3(256), 0, st, A, lda, B, ldb, C, ldc, M, N, K);
  else hipLaunchKernelGGL(k_sgemm<1>, g, dim3(256), 0, st, A, lda, B, ldb, C, ldc, M, N, K);
}
constexpr size_t MB = 1u << 20;
inline void mixer_gla(hipStream_t st, const In& I, const float* hin, float* hout, char* scr) {
  float* U = (float*)scr; float* BIG = (float*)(scr + 64 * MB);
  hipLaunchKernelGGL(k_rmsnorm, dim3(L), dim3(256), 0, st, hin, I.g_pre_mix + 0 * DM, U);
  sgemm(st, 0, U, DM, I.gla_w_in, GIN, BIG, GIN, L, GIN, DM);
  hipLaunchKernelGGL(k_gla_scan, dim3(32, 4), dim3(256), 0, st, (const float*)BIG, I.gla_wgk_f, I.gla_bgk_f, U, 0);
  hipLaunchKernelGGL(k_gla_scan, dim3(32, 4), dim3(256), 0, st, (const float*)BIG, I.gla_wgk_b, I.gla_bgk_b, U, 1);
  hipLaunchKernelGGL(k_gla_gate, dim3(L), dim3(256), 0, st, U, (const float*)BIG, I.gla_g_head);
  sgemm(st, 0, U, DM, I.gla_w_out, DM, BIG, DM, L, DM, DM);
  hipLaunchKernelGGL(k_add_rmsnorm, dim3(L), dim3(256), 0, st, hin, (const float*)BIG, I.g_post_mix + 0 * DM, hout);
}
inline void mixer_attn(hipStream_t st, const In& I, const float* hin, float* hout, char* scr) {
  float* U = (float*)scr; float* BIG = (float*)(scr + 64 * MB); float* MIX = (float*)(scr + 64 * MB + 100 * MB);
  hipLaunchKernelGGL(k_rmsnorm, dim3(L), dim3(256), 0, st, hin, I.g_pre_mix + 1 * DM, U);
  sgemm(st, 0, U, DM, I.attn_w_in, AIN, BIG, AIN, L, AIN, DM);
  hipLaunchKernelGGL(k_qk_norm_rope, dim3(L, 20), dim3(128), 0, st, BIG, I.attn_gq, I.attn_gk);
  hipLaunchKernelGGL(k_attn, dim3(L / 32, 16), dim3(128), 0, st, (const float*)BIG, U);
  sgemm(st, 0, U, DM, I.attn_w_out, DM, MIX, DM, L, DM, DM);
  hipLaunchKernelGGL(k_add_rmsnorm, dim3(L), dim3(256), 0, st, hin, (const float*)MIX, I.g_post_mix + 1 * DM, hout);
}
inline void mlp(hipStream_t st, const In& I, int li, const float* hin, float* hout, char* scr) {
  float* U = (float*)scr; float* HID = (float*)(scr + 64 * MB); float* Mo = (float*)(scr + 128 * MB);
  hipLaunchKernelGGL(k_rmsnorm, dim3(L), dim3(256), 0, st, hin, I.g_pre_mlp + li * DM, U);
  for (int c = 0; c < 4; ++c) {
    sgemm(st, 1, U + (size_t)c * 2048 * DM, DM, I.w_up + (size_t)li * DM * DFF, DFF, HID, DFF, 2048, DFF, DM);
    sgemm(st, 0, HID, DFF, I.w_down + (size_t)li * DFF * DM, DM, Mo + (size_t)c * 2048 * DM, DM, 2048, DM, DFF);
  }
  hipLaunchKernelGGL(k_add_rmsnorm, dim3(L), dim3(256), 0, st, hin, (const float*)Mo, I.g_post_mlp + li * DM, hout);
}
inline void ple(hipStream_t st, const In& I, int li, const float* hin, float* hout, char* scr) {
  float* G = (float*)scr; float* E = (float*)(scr + 64 * MB);
  sgemm(st, 0, hin, DM, I.w_ple_gate + (size_t)li * DM * DM, DM, G, DM, L, DM, DM);
  sgemm(st, 0, I.p + (size_t)li * L * PLE, PLE, I.w_ple_proj + (size_t)li * PLE * DM, DM, E, DM, L, DM, PLE);
  hipLaunchKernelGGL(k_ple_mul, dim3((unsigned)(((size_t)L * DM + 255) / 256)), dim3(256), 0, st, G, (const float*)E, (size_t)L * DM);
  hipLaunchKernelGGL(k_add_rmsnorm, dim3(L), dim3(256), 0, st, hin, (const float*)G, I.g_ple + li * DM, hout);
}
}
extern "C" void kernel_launch(void* const* d_in, const int* in_sizes, int n_in, void* d_out, int out_size, void* d_ws, size_t ws_size, hipStream_t stream) {
  if (n_in != 22 || out_size != nv::L * nv::DM || ws_size < (size_t)480 * nv::MB) { fprintf(stderr, "kernel_launch: unexpected shapes n_in %d out %d ws %zu\n", n_in, out_size, ws_size); return; }
  nv::In I;
  const float** ip = (const float**)&I;
  for (int i = 0; i < 22; ++i) ip[i] = (const float*)d_in[i];
  float* h = (float*)d_out; char* scr = (char*)d_ws + (size_t)210 * nv::MB;
  nv::mixer_gla(stream, I, I.x, h, scr);
  nv::mlp(stream, I, 0, h, h, scr);
  nv::ple(stream, I, 0, h, h, scr);
  nv::mixer_attn(stream, I, h, h, scr);
  nv::mlp(stream, I, 1, h, h, scr);
  nv::ple(stream, I, 1, h, h, scr);
}
```

```cpp
#include <hip/hip_runtime.h>
#include <hip/hip_bf16.h>
#include <cstdio>
#include <cstdint>
#include <cmath>
namespace nv {
constexpr int L = 8192, DM = 2048, DFF = 8192, PLE = 256;
constexpr int GIN = 6176, AIN = 3072;
constexpr float EPS = 1e-6f;

__device__ __forceinline__ float block_sum_256(float v, float* red) {
  for (int o = 32; o > 0; o >>= 1) v += __shfl_xor(v, o);
  __syncthreads();
  if ((threadIdx.x & 63) == 0) red[threadIdx.x >> 6] = v;
  __syncthreads();
  return red[0] + red[1] + red[2] + red[3];
}
__global__ __launch_bounds__(256) void k_rmsnorm(const float* __restrict__ in, const float* __restrict__ gain, float* __restrict__ out) {
  __shared__ float red[4];
  const float* r = in + (size_t)blockIdx.x * DM; float v[8]; float s = 0.f;
#pragma unroll
  for (int i = 0; i < 8; ++i) { v[i] = r[threadIdx.x + 256 * i]; s += v[i] * v[i]; }
  s = block_sum_256(s, red); const float rs = rsqrtf(s / DM + EPS);
#pragma unroll
  for (int i = 0; i < 8; ++i) out[(size_t)blockIdx.x * DM + threadIdx.x + 256 * i] = v[i] * rs * gain[threadIdx.x + 256 * i];
}
__global__ __launch_bounds__(256) void k_add_rmsnorm(const float* __restrict__ hin, const float* __restrict__ t, const float* __restrict__ gain, float* __restrict__ hout) {
  __shared__ float red[4];
  const float* r = t + (size_t)blockIdx.x * DM; float v[8]; float s = 0.f;
#pragma unroll
  for (int i = 0; i < 8; ++i) { v[i] = r[threadIdx.x + 256 * i]; s += v[i] * v[i]; }
  s = block_sum_256(s, red); const float rs = rsqrtf(s / DM + EPS);
#pragma unroll
  for (int i = 0; i < 8; ++i) { const size_t o = (size_t)blockIdx.x * DM + threadIdx.x + 256 * i; hout[o] = hin[o] + v[i] * rs * gain[threadIdx.x + 256 * i]; }
}
template <int EPI>
__global__ __launch_bounds__(256) void k_sgemm(const float* __restrict__ A, int lda, const float* __restrict__ B, int ldb, float* __restrict__ C, int ldc, int M, int N, int K) {
  __shared__ float As[16][68];
  __shared__ float Bs[16][68];
  const int bm = blockIdx.y * 64, bn = blockIdx.x * 64, tid = threadIdx.x, tx = tid & 15, ty = tid >> 4;
  float acc[4][4];
#pragma unroll
  for (int i = 0; i < 4; ++i)
#pragma unroll
    for (int j = 0; j < 4; ++j) acc[i][j] = 0.f;
  const int ar = tid >> 2, ak = (tid & 3) * 4, bk = tid >> 4, bn4 = (tid & 15) * 4;
  for (int k0 = 0; k0 < K; k0 += 16) {
    const float4 a4 = *(const float4*)(A + (size_t)(bm + ar) * lda + k0 + ak);
    As[ak + 0][ar] = a4.x; As[ak + 1][ar] = a4.y; As[ak + 2][ar] = a4.z; As[ak + 3][ar] = a4.w;
#pragma unroll
    for (int i = 0; i < 4; ++i) { const int c = bn + bn4 + i; Bs[bk][bn4 + i] = (c < N) ? B[(size_t)(k0 + bk) * ldb + c] : 0.f; }
    __syncthreads();
#pragma unroll
    for (int k = 0; k < 16; ++k) {
      float a[4], b[4];
#pragma unroll
      for (int i = 0; i < 4; ++i) { a[i] = As[k][ty * 4 + i]; b[i] = Bs[k][tx * 4 + i]; }
#pragma unroll
      for (int i = 0; i < 4; ++i)
#pragma unroll
        for (int j = 0; j < 4; ++j) acc[i][j] = fmaf(a[i], b[j], acc[i][j]);
    }
    __syncthreads();
  }
#pragma unroll
  for (int i = 0; i < 4; ++i)
#pragma unroll
    for (int j = 0; j < 4; ++j) { const int c = bn + tx * 4 + j; if (c < N) { float v = acc[i][j]; if (EPI == 1) { v = v > 0.f ? v : 0.f; v = v * v; } C[(size_t)(bm + ty * 4 + i) * ldc + c] = v; } }
}
__device__ __forceinline__ float logsigmoidf(float z) { return fminf(z, 0.f) - log1pf(expf(-fabsf(z))); }
__global__ __launch_bounds__(256) void k_gla_scan(const float* __restrict__ proj, const float* __restrict__ wgk, const float* __restrict__ bgk, float* __restrict__ o, int dir) {
  const int h = blockIdx.y, e0 = blockIdx.x * 16, tid = threadIdx.x, e = tid & 15, dg = tid >> 4;
  __shared__ float qs[256], ks[256], as[256], vs[16], red[16][17], kprev[256], vprev[16];
  float S[16];
#pragma unroll
  for (int i = 0; i < 16; ++i) S[i] = 0.f;
  float wcol[16];
#pragma unroll
  for (int r = 0; r < 16; ++r) wcol[r] = wgk[r * 1024 + h * 256 + tid];
  const float bb = bgk[h * 256 + tid];
  const int lroff = dir == 0 ? 6144 : 6160;
  kprev[tid] = 0.f; if (tid < 16) vprev[tid] = 0.f;
  for (int step = 0; step < L; ++step) {
    const int t = dir == 0 ? step : L - 1 - step;
    const float* row = proj + (size_t)t * GIN;
    float z = bb;
#pragma unroll
    for (int r = 0; r < 16; ++r) z = fmaf(row[lroff + r], wcol[r], z);
    const float la = logsigmoidf(z) * (1.f / 16.f);
    const float kreg = row[1024 + h * 256 + tid];
    float vreg = 0.f; if (tid < 16) vreg = row[2048 + h * 512 + e0 + tid];
    as[tid] = expf(la); qs[tid] = row[h * 256 + tid] * 0.0625f; ks[tid] = kreg; if (tid < 16) vs[tid] = vreg;
    __syncthreads();
    float part = 0.f;
    if (dir == 0) {
#pragma unroll
      for (int i = 0; i < 16; ++i) { const int d = dg * 16 + i; S[i] = fmaf(as[d], S[i], ks[d] * vs[e]); part = fmaf(qs[d], S[i], part); }
    } else {
#pragma unroll
      for (int i = 0; i < 16; ++i) { const int d = dg * 16 + i; S[i] = as[d] * (S[i] + kprev[d] * vprev[e]); part = fmaf(qs[d], S[i], part); }
    }
    red[dg][e] = part;
    __syncthreads();
    if (tid < 16) { float s = 0.f;
#pragma unroll
      for (int g = 0; g < 16; ++g) s += red[g][tid];
      float* op = o + (size_t)t * DM + h * 512 + e0 + tid; if (dir == 0) *op = s; else *op += s; }
    kprev[tid] = kreg; if (tid < 16) vprev[tid] = vreg;
  }
}
__global__ __launch_bounds__(256) void k_gla_gate(float* __restrict__ o, const float* __restrict__ proj, const float* __restrict__ ghead) {
  __shared__ float red[4];
  const int t = blockIdx.x;
  for (int h = 0; h < 4; ++h) {
    float* r = o + (size_t)t * DM + h * 512; const float v0 = r[threadIdx.x], v1 = r[threadIdx.x + 256];
    const float s = block_sum_256(v0 * v0 + v1 * v1, red); const float rs = rsqrtf(s / 512.f + EPS);
    const float g0 = proj[(size_t)t * GIN + 4096 + h * 512 + threadIdx.x], g1 = proj[(size_t)t * GIN + 4096 + h * 512 + threadIdx.x + 256];
    r[threadIdx.x] = v0 * rs * ghead[threadIdx.x] * (g0 / (1.f + expf(-g0)));
    r[threadIdx.x + 256] = v1 * rs * ghead[threadIdx.x + 256] * (g1 / (1.f + expf(-g1)));
    __syncthreads();
  }
}
__global__ __launch_bounds__(128) void k_qk_norm_rope(float* __restrict__ proj, const float* __restrict__ gq, const float* __restrict__ gk) {
  __shared__ float y[128]; __shared__ float red[2];
  const int t = blockIdx.x, hh = blockIdx.y, i = threadIdx.x;
  float* p = proj + (size_t)t * AIN + hh * 128; const float* g = hh < 16 ? gq : gk;
  const float v = p[i]; float s = v * v;
  for (int o = 32; o > 0; o >>= 1) s += __shfl_xor(s, o);
  if ((i & 63) == 0) red[i >> 6] = s;
  __syncthreads();
  const float rs = rsqrtf((red[0] + red[1]) / 128.f + EPS);
  y[i] = v * rs * g[i];
  __syncthreads();
  const int a = i >> 6, w = i & 63, b = w >> 5, j = w & 31;
  const float pos = (float)(a == 0 ? (t / 64) : (t % 64));
  const float invf = 1.0f / powf(10000.0f, (float)(2 * j) / 64.0f);
  const float ang = pos * invf, c = cosf(ang), sn = sinf(ang);
  const float out = b == 0 ? (y[i] * c - y[i + 32] * sn) : (y[i] * c + y[i - 32] * sn);
  p[i] = out;
}
__global__ __launch_bounds__(128) void k_attn(const float* __restrict__ proj, float* __restrict__ o) {
  __shared__ float Ks[32][132]; __shared__ float Vs[32][132];
  const int h = blockIdx.y, kvh = h >> 2, tid = threadIdx.x, r = tid >> 2, p = tid & 3, t = blockIdx.x * 32 + r;
  float q[32], acc[32];
#pragma unroll
  for (int i = 0; i < 32; ++i) { q[i] = proj[(size_t)t * AIN + h * 128 + p * 32 + i] * 0.08838834764831845f; acc[i] = 0.f; }
  float m = -1e30f, l = 0.f;
  for (int k0 = 0; k0 < L; k0 += 32) {
    __syncthreads();
#pragma unroll
    for (int i = 0; i < 32; ++i) { const int idx = i * 128 + tid, rr = idx >> 7, cc = idx & 127;
      Ks[rr][(cc >> 5) * 33 + (cc & 31)] = proj[(size_t)(k0 + rr) * AIN + 2048 + kvh * 128 + cc];
      Vs[rr][(cc >> 5) * 33 + (cc & 31)] = proj[(size_t)(k0 + rr) * AIN + 2560 + kvh * 128 + cc]; }
    __syncthreads();
    float s[32]; float tm = -1e30f;
#pragma unroll
    for (int j = 0; j < 32; ++j) { float d = 0.f;
#pragma unroll
      for (int i = 0; i < 32; ++i) d = fmaf(q[i], Ks[j][p * 33 + i], d);
      d += __shfl_xor(d, 1); d += __shfl_xor(d, 2); s[j] = d; tm = fmaxf(tm, d); }
    const float mn = fmaxf(m, tm), corr = expf(m - mn); l *= corr;
#pragma unroll
    for (int i = 0; i < 32; ++i) acc[i] *= corr;
#pragma unroll
    for (int j = 0; j < 32; ++j) { const float pj = expf(s[j] - mn); l += pj;
#pragma unroll
      for (int i = 0; i < 32; ++i) acc[i] = fmaf(pj, Vs[j][p * 33 + i], acc[i]); }
    m = mn;
  }
  const float il = 1.f / l;
  const int orow = (t & 127) * 64 + (t >> 7);
#pragma unroll
  for (int i = 0; i < 32; ++i) o[(size_t)orow * DM + h * 128 + p * 32 + i] = acc[i] * il;
}
__global__ __launch_bounds__(256) void k_ple_mul(float* __restrict__ gate, const float* __restrict__ e, size_t n) {
  const size_t i = (size_t)blockIdx.x * 256 + threadIdx.x; if (i < n) gate[i] = e[i] / (1.f + expf(-gate[i]));
}

struct In {
  const float *x, *p, *g_pre_mix, *g_post_mix, *g_pre_mlp, *g_post_mlp, *g_ple, *w_up, *w_down, *w_ple_proj, *w_ple_gate,
      *gla_w_in, *gla_wgk_f, *gla_bgk_f, *gla_wgk_b, *gla_bgk_b, *gla_g_head, *gla_w_out, *attn_w_in, *attn_gq, *attn_gk, *attn_w_out;
};
inline void sgemm(hipStream_t st, int epi, const float* A, int lda, const float* B, int ldb, float* C, int ldc, int M, int N, int K) {
  dim3 g((N + 63) / 64, M / 64);
  if (epi == 0) hipLaunchKernelGGL(k_sgemm<0>, g, dim3(256), 0, st, A, lda, B, ldb, C, ldc, M, N, K);
  else hipLaunchKernelGGL(k_sgemm<1>, g, dim3(256), 0, st, A, lda, B, ldb, C, ldc, M, N, K);
}
constexpr size_t MB = 1u << 20;
inline void mixer_gla(hipStream_t st, const In& I, const float* hin, float* hout, char* scr) {
  float* U = (float*)scr; float* BIG = (float*)(scr + 64 * MB);
  hipLaunchKernelGGL(k_rmsnorm, dim3(L), dim3(256), 0, st, hin, I.g_pre_mix + 0 * DM, U);
  sgemm(st, 0, U, DM, I.gla_w_in, GIN, BIG, GIN, L, GIN, DM);
  hipLaunchKernelGGL(k_gla_scan, dim3(32, 4), dim3(256), 0, st, (const float*)BIG, I.gla_wgk_f, I.gla_bgk_f, U, 0);
  hipLaunchKernelGGL(k_gla_scan, dim3(32, 4), dim3(256), 0, st, (const float*)BIG, I.gla_wgk_b, I.gla_bgk_b, U, 1);
  hipLaunchKernelGGL(k_gla_gate, dim3(L), dim3(256), 0, st, U, (const float*)BIG, I.gla_g_head);
  sgemm(st, 0, U, DM, I.gla_w_out, DM, BIG, DM, L, DM, DM);
  hipLaunchKernelGGL(k_add_rmsnorm, dim3(L), dim3(256), 0, st, hin, (const float*)BIG, I.g_post_mix + 0 * DM, hout);
}
inline void mixer_attn(hipStream_t st, const In& I, const float* hin, float* hout, char* scr) {
  float* U = (float*)scr; float* BIG = (float*)(scr + 64 * MB); float* MIX = (float*)(scr + 64 * MB + 100 * MB);
  hipLaunchKernelGGL(k_rmsnorm, dim3(L), dim3(256), 0, st, hin, I.g_pre_mix + 1 * DM, U);
  sgemm(st, 0, U, DM, I.attn_w_in, AIN, BIG, AIN, L, AIN, DM);
  hipLaunchKernelGGL(k_qk_norm_rope, dim3(L, 20), dim3(128), 0, st, BIG, I.attn_gq, I.attn_gk);
  hipLaunchKernelGGL(k_attn, dim3(L / 32, 16), dim3(128), 0, st, (const float*)BIG, U);
  sgemm(st, 0, U, DM, I.attn_w_out, DM, MIX, DM, L, DM, DM);
  hipLaunchKernelGGL(k_add_rmsnorm, dim3(L), dim3(256), 0, st, hin, (const float*)MIX, I.g_post_mix + 1 * DM, hout);
}
inline void mlp(hipStream_t st, const In& I, int li, const float* hin, float* hout, char* scr) {
  float* U = (float*)scr; float* HID = (float*)(scr + 64 * MB); float* Mo = (float*)(scr + 128 * MB);
  hipLaunchKernelGGL(k_rmsnorm, dim3(L), dim3(256), 0, st, hin, I.g_pre_mlp + li * DM, U);
  for (int c = 0; c < 4; ++c) {
    sgemm(st, 1, U + (size_t)c * 2048 * DM, DM, I.w_up + (size_t)li * DM * DFF, DFF, HID, DFF, 2048, DFF, DM);
    sgemm(st, 0, HID, DFF, I.w_down + (size_t)li * DFF * DM, DM, Mo + (size_t)c * 2048 * DM, DM, 2048, DM, DFF);
  }
  hipLaunchKernelGGL(k_add_rmsnorm, dim3(L), dim3(256), 0, st, hin, (const float*)Mo, I.g_post_mlp + li * DM, hout);
}
inline void ple(hipStream_t st, const In& I, int li, const float* hin, float* hout, char* scr) {
  float* G = (float*)scr; float* E = (float*)(scr + 64 * MB);
  sgemm(st, 0, hin, DM, I.w_ple_gate + (size_t)li * DM * DM, DM, G, DM, L, DM, DM);
  sgemm(st, 0, I.p + (size_t)li * L * PLE, PLE, I.w_ple_proj + (size_t)li * PLE * DM, DM, E, DM, L, DM, PLE);
  hipLaunchKernelGGL(k_ple_mul, dim3((unsigned)(((size_t)L * DM + 255) / 256)), dim3(256), 0, st, G, (const float*)E, (size_t)L * DM);
  hipLaunchKernelGGL(k_add_rmsnorm, dim3(L), dim3(256), 0, st, hin, (const float*)G, I.g_ple + li * DM, hout);
}
}
namespace pg8 {
#define PG8_LAS __attribute__((address_space(3)))
typedef unsigned short bf16_t;
typedef short bf16x8 __attribute__((ext_vector_type(8)));
typedef float f32x4 __attribute__((ext_vector_type(4)));
typedef unsigned u32x4 __attribute__((ext_vector_type(4)));
constexpr int BM = 256, BK = 64, HALF = 128, HTB = HALF * BK * 2  , STAGE_BYTES = 8 * HTB, NXCD = 8, WGM = 8;

__host__ __device__ __forceinline__ int lds_byte(int r, int c) { const int st = (r >> 4) * 2 + (c >> 5), rr = r & 15, cc = c & 31, ob = rr * 64 + cc * 2; return st * 1024 + (ob ^ (((ob >> 9) & 1) << 5)); }
__host__ __device__ __forceinline__ void stage_rc(int b, int& R, int& C) { const int st = b / 1024, sb = b % 1024, swz = sb ^ (((sb >> 9) & 1) << 5); R = (st >> 1) * 16 + swz / 64; C = (st & 1) * 32 + (swz % 64) / 2; }
__host__ __device__ __forceinline__ int perm32(int rho) { const int n = rho >> 4, i = rho & 15; return 8 * (i >> 2) + 4 * n + (i & 3); }

struct Unit { int pm, pn; };
struct Gemm { const bf16_t* A; const bf16_t* Bt; int M, N, K; };

struct StaticOrder {
    int nM, nN, nwg, G, c;
    __host__ __device__ void init(int M, int N, int G_, int c_) { nM = M / BM; nN = N / BM; nwg = nM * nN; G = G_; c = c_; }
    __host__ __device__ bool next(int i, Unit& u) const {
        const long L = (long)i * G + c; if (L >= nwg) return false;
        int wgid = (int)L; { const int q = nwg / NXCD, r = nwg % NXCD, xcd = wgid % NXCD, off = wgid / NXCD; wgid = (xcd < r ? xcd * (q + 1) : r * (q + 1) + (xcd - r) * q) + off; }
        const int nig = WGM * nN, gid = wgid / nig, fm = gid * WGM, gsz = (nM - fm) < WGM ? (nM - fm) : WGM;
        u.pm = fm + ((wgid % nig) % gsz); u.pn = (wgid % nig) / gsz; return true;
    }
    __device__ __forceinline__ void a_ready(const Unit&) const {}
    __device__ __forceinline__ void done(const Unit&) const {}
};

__device__ __forceinline__ unsigned cvt_pk_bf16(float lo, float hi) { unsigned r; asm volatile("v_cvt_pk_bf16_f32 %0, %1, %2" : "=v"(r) : "v"(lo), "v"(hi)); return r; }
typedef float f32x2 __attribute__((ext_vector_type(2)));
__device__ __forceinline__ f32x2 gelu_pk(f32x2 v) {
    const f32x2 av = __builtin_elementwise_abs(v), d = av * 0.2316418882f + 1.0f;
    f32x2 t; t.x = __builtin_amdgcn_rcpf(d.x); t.y = __builtin_amdgcn_rcpf(d.y);
    f32x2 q = t * 0.5307027145f + (-0.7265760135f); q = q * t + 0.7107068705f; q = q * t + (-0.142248368f); q = q * t + 0.127414796f; q = q * t;
    const f32x2 s = (v * v) * (-0.72134752044f);
    f32x2 e; e.x = __builtin_amdgcn_exp2f(s.x); e.y = __builtin_amdgcn_exp2f(s.y);
    const f32x2 m = v * (q * e), r = v - m;
    f32x2 o; o.x = v.x < 0.f ? m.x : r.x; o.y = v.y < 0.f ? m.y : r.y; return o;
}

template <int ACT  > struct EpiBf16 {
    static constexpr bool PERM = true, AFTER_DRAIN = false; static_assert(ACT == 0 || ACT == 1, "EpiBf16: ACT is 0 (none) or 1 (gelu_pk)");
    bf16_t* O; int ldc; const float* bias; int split_cols; size_t split_stride; float scale0;
    __device__ __forceinline__ void operator()(const f32x4 (&acc)[2][2][4][2], const Unit& u, int wr, int wc, int fr, int fq) const {
        const int row0 = u.pm * BM + wr * 64 + fr; int colt = u.pn * BM; bf16_t* base = O;
        float sc = 1.f; if (split_cols) { const int t = colt / split_cols; base += (size_t)t * split_stride; colt -= t * split_cols; if (t == 0) sc = scale0; }
        const int col0 = colt + wc * 32 + 8 * fq, bcol0 = u.pn * BM + wc * 32 + 8 * fq;
        f32x4 bv[2][2];
#pragma unroll
        for (int bj = 0; bj < 2; ++bj)
#pragma unroll
            for (int n = 0; n < 2; ++n) bv[bj][n] = bias ? *(const f32x4*)(bias + bcol0 + bj * HALF + 4 * n) : (f32x4){0.f, 0.f, 0.f, 0.f};
#pragma unroll
        for (int ai = 0; ai < 2; ++ai)
#pragma unroll
            for (int m = 0; m < 4; ++m) { bf16_t* rowp = base + (size_t)(row0 + ai * HALF + m * 16) * ldc + col0;
#pragma unroll
                for (int bj = 0; bj < 2; ++bj) { f32x4 v0 = acc[ai][bj][m][0] + bv[bj][0], v1 = acc[ai][bj][m][1] + bv[bj][1];
                    if (ACT == 1) { f32x2 a = gelu_pk((f32x2){v0[0], v0[1]}), b = gelu_pk((f32x2){v0[2], v0[3]}), c = gelu_pk((f32x2){v1[0], v1[1]}), d = gelu_pk((f32x2){v1[2], v1[3]});
                        v0 = (f32x4){a.x, a.y, b.x, b.y}; v1 = (f32x4){c.x, c.y, d.x, d.y}; }
                    v0 = v0 * sc; v1 = v1 * sc; u32x4 w; w.x = cvt_pk_bf16(v0[0], v0[1]); w.y = cvt_pk_bf16(v0[2], v0[3]); w.z = cvt_pk_bf16(v1[0], v1[1]); w.w = cvt_pk_bf16(v1[2], v1[3]);
                    *(u32x4*)(rowp + bj * HALF) = w; } }
    }
};

struct PanelStats {
    unsigned* xbuf;
    unsigned* cnt;
    unsigned* tmo;
    int ntn; float eps;
    unsigned code;
    __device__ __forceinline__ bool run(const f32x4 (&v)[2][2][4][2], const Unit& u, int wr, int wc, int fr, int fq, PG8_LAS unsigned char* lds, int wid, int lane) const {
        typedef float f32x2v __attribute__((ext_vector_type(2)));
        PG8_LAS f32x2v* P = (PG8_LAS f32x2v*)lds;
        PG8_LAS f32x2v* S = (PG8_LAS f32x2v*)(lds + 8192);
        PG8_LAS unsigned* flag = (PG8_LAS unsigned*)(lds + 8192 + 2048);
#pragma unroll
        for (int ai = 0; ai < 2; ++ai)
#pragma unroll
            for (int m = 0; m < 4; ++m) {
                float s = 0.f;
#pragma unroll
                for (int bj = 0; bj < 2; ++bj)
#pragma unroll
                    for (int n = 0; n < 2; ++n) { const f32x4 x = v[ai][bj][m][n]; s += (x[0] + x[1]) + (x[2] + x[3]); }
                s += __shfl_xor(s, 16); s += __shfl_xor(s, 32);
                const float mw = s * (1.0f / 64.0f); float q = 0.f;
#pragma unroll
                for (int bj = 0; bj < 2; ++bj)
#pragma unroll
                    for (int n = 0; n < 2; ++n) { const f32x4 d = v[ai][bj][m][n] - mw; q += (d[0] * d[0] + d[1] * d[1]) + (d[2] * d[2] + d[3] * d[3]); }
                q += __shfl_xor(q, 16); q += __shfl_xor(q, 32);
                if (fq == 0) P[(ai * HALF + wr * 64 + m * 16 + fr) * 4 + wc] = (f32x2v){mw, q};
            }
        asm volatile("s_waitcnt lgkmcnt(0)" ::: "memory"); __builtin_amdgcn_s_barrier(); asm volatile("" ::: "memory");
#if defined(BROKEN_EXCHANGE_NO_WAIT)
#warning BROKEN CONTROL BUILD: the row-statistics exchange does not wait; results are wrong by design
        if (blockIdx.x >= 64) { const long long t0_ = clock64(); while (clock64() - t0_ < 60000) __builtin_amdgcn_s_sleep(8); }
#endif
        const int row = wid * 32 + (lane & 31);
        if (lane < 32) {
            const f32x2v a = P[row * 4 + 0], b = P[row * 4 + 1], c = P[row * 4 + 2], d = P[row * 4 + 3];
            const float mt = (a.x + b.x + c.x + d.x) * 0.25f;
            const float da = a.x - mt, db = b.x - mt, dc = c.x - mt, dd = d.x - mt;
            const float m2 = (a.y + b.y) + (c.y + d.y) + 64.0f * ((da * da + db * db) + (dc * dc + dd * dd));
            unsigned long long* slot = (unsigned long long*)xbuf + ((size_t)(u.pm * BM + row) * 4 + u.pn);
            __hip_atomic_store(slot, ((unsigned long long)__float_as_uint(m2) << 32) | __float_as_uint(mt), __ATOMIC_RELAXED, __HIP_MEMORY_SCOPE_AGENT);
        }
        asm volatile("s_waitcnt vmcnt(0)" ::: "memory");
        if (lane == 0) __hip_atomic_fetch_add(cnt + 64 * u.pm, 1u, __ATOMIC_RELAXED, __HIP_MEMORY_SCOPE_AGENT);
        if (wid == 0) {
            bool dead = false; const unsigned long long t0 = __builtin_amdgcn_s_memrealtime(); const unsigned want = 8u * (unsigned)ntn;
            for (;;) {
#if defined(BROKEN_EXCHANGE_NO_WAIT)
                break;
#endif
                if ((unsigned)__builtin_amdgcn_readfirstlane(__hip_atomic_load(cnt + 64 * u.pm, __ATOMIC_RELAXED, __HIP_MEMORY_SCOPE_AGENT)) >= want) break;
                if (__builtin_amdgcn_s_memrealtime() - t0 > 2000000ull) {
                    if (lane == 0) { unsigned expect = 0u; __hip_atomic_compare_exchange_strong(tmo + 1, &expect, code | (unsigned)(u.pm & 0xff), __ATOMIC_RELAXED, __ATOMIC_RELAXED, __HIP_MEMORY_SCOPE_AGENT);
                                     __hip_atomic_store(tmo, 1u, __ATOMIC_RELAXED, __HIP_MEMORY_SCOPE_AGENT); }
                    dead = true; break; }
                __builtin_amdgcn_s_sleep(2);
            }
            __builtin_amdgcn_fence(__ATOMIC_ACQUIRE, "agent");
            if (lane == 0) flag[0] = dead ? 1u : 0u;
        }
        asm volatile("s_waitcnt vmcnt(0) lgkmcnt(0)" ::: "memory"); __builtin_amdgcn_s_barrier(); asm volatile("" ::: "memory");
        const bool bad = flag[0] != 0u;
        if (lane < 32) {
            const unsigned long long* slot = (const unsigned long long*)xbuf + (size_t)(u.pm * BM + row) * 4; float mt[4], m2[4]; float ms = 0.f;
#pragma unroll
            for (int t = 0; t < 4; ++t) { if (t < ntn) { const unsigned long long w = __hip_atomic_load(slot + t, __ATOMIC_RELAXED, __HIP_MEMORY_SCOPE_AGENT); mt[t] = __uint_as_float((unsigned)w); m2[t] = __uint_as_float((unsigned)(w >> 32)); } else { mt[t] = 0.f; m2[t] = 0.f; } ms += mt[t]; }
            const float mean = ms / (float)ntn; float q = 0.f;
#pragma unroll
            for (int t = 0; t < 4; ++t) if (t < ntn) { const float dm = mt[t] - mean; q += m2[t] + 256.0f * dm * dm; }
            S[row] = (f32x2v){mean, 1.0f / sqrtf(q / (256.0f * (float)ntn) + eps)};
        }
        asm volatile("s_waitcnt lgkmcnt(0)" ::: "memory"); __builtin_amdgcn_s_barrier(); asm volatile("" ::: "memory");
        return bad;
    }
};
struct EpiLnRes {
    static constexpr bool PERM = false, AFTER_DRAIN = true;
    const float* base; float* out; int ldc; const float* bias; PanelStats st; unsigned poison;
    __device__ __forceinline__ void fused(f32x4 (&acc)[2][2][4][2], const Unit& u, int wr, int wc, int fr, int fq, PG8_LAS unsigned char* lds, int wid, int lane) const {
        typedef float f32x2v __attribute__((ext_vector_type(2)));
        const PG8_LAS f32x2v* S = (const PG8_LAS f32x2v*)(lds + 8192);
        const int col0 = u.pn * BM + wc * 32 + 4 * fq;
#pragma unroll
        for (int bj = 0; bj < 2; ++bj)
#pragma unroll
            for (int n = 0; n < 2; ++n) { const f32x4 bv = bias ? *(const f32x4*)(bias + col0 + bj * HALF + n * 16) : (f32x4){0.f, 0.f, 0.f, 0.f};
#pragma unroll
                for (int ai = 0; ai < 2; ++ai)
#pragma unroll
                    for (int m = 0; m < 4; ++m) acc[ai][bj][m][n] += bv; }
        f32x4 pre[4][2][2];
#pragma unroll
        for (int m = 0; m < 4; ++m) { const size_t off = (size_t)(u.pm * BM + wr * 64 + m * 16 + fr) * ldc + col0;
#pragma unroll
            for (int bj = 0; bj < 2; ++bj)
#pragma unroll
                for (int n = 0; n < 2; ++n) pre[m][bj][n] = *(const f32x4*)(base + off + bj * HALF + n * 16); }
        const bool bad = st.run(acc, u, wr, wc, fr, fq, lds, wid, lane) || poison != 0u;
        const float qnan = __builtin_nanf("");
#pragma unroll
        for (int ai = 0; ai < 2; ++ai)
#pragma unroll
            for (int m = 0; m < 4; ++m) { const int r = ai * HALF + wr * 64 + m * 16 + fr; const f32x2v sr = S[r]; const size_t off = (size_t)(u.pm * BM + r) * ldc + col0;
#pragma unroll
                for (int bj = 0; bj < 2; ++bj)
#pragma unroll
                    for (int n = 0; n < 2; ++n) { const f32x4 bs = ai == 0 ? pre[m][bj][n] : *(const f32x4*)(base + off + bj * HALF + n * 16); f32x4 o = bs + (acc[ai][bj][m][n] - sr.x) * sr.y;
                        if (bad) o = (f32x4){qnan, qnan, qnan, qnan}; *(f32x4*)(out + off + bj * HALF + n * 16) = o; }
                if (m & 1) asm volatile("" ::: "memory"); }
    }
};
struct EpiLnResLn {
    static constexpr bool PERM = false, AFTER_DRAIN = true;
    const float* base; float* out; bf16_t* xn; int ldc; const float* bias; PanelStats st1, st2; unsigned poison;
    __device__ __forceinline__ void fused(f32x4 (&acc)[2][2][4][2], const Unit& u, int wr, int wc, int fr, int fq, PG8_LAS unsigned char* lds, int wid, int lane) const {
        typedef float f32x2v __attribute__((ext_vector_type(2))); typedef unsigned u32x2v __attribute__((ext_vector_type(2)));
        const PG8_LAS f32x2v* S = (const PG8_LAS f32x2v*)(lds + 8192);
        const int col0 = u.pn * BM + wc * 32 + 4 * fq;
#pragma unroll
        for (int bj = 0; bj < 2; ++bj)
#pragma unroll
            for (int n = 0; n < 2; ++n) { const f32x4 bv = bias ? *(const f32x4*)(bias + col0 + bj * HALF + n * 16) : (f32x4){0.f, 0.f, 0.f, 0.f};
#pragma unroll
                for (int ai = 0; ai < 2; ++ai)
#pragma unroll
                    for (int m = 0; m < 4; ++m) acc[ai][bj][m][n] += bv; }
        bool bad = st1.run(acc, u, wr, wc, fr, fq, lds, wid, lane) || poison != 0u;
        const float qnan = __builtin_nanf("");
#pragma unroll
        for (int ai = 0; ai < 2; ++ai)
#pragma unroll
            for (int m = 0; m < 4; ++m) { const int r = ai * HALF + wr * 64 + m * 16 + fr; const f32x2v sr = S[r]; const size_t off = (size_t)(u.pm * BM + r) * ldc + col0;
#pragma unroll
                for (int bj = 0; bj < 2; ++bj)
#pragma unroll
                    for (int n = 0; n < 2; ++n) { const f32x4 bs = *(const f32x4*)(base + off + bj * HALF + n * 16); acc[ai][bj][m][n] = bs + (acc[ai][bj][m][n] - sr.x) * sr.y; }
                asm volatile("" : "+v"(acc[ai][0][m][0]), "+v"(acc[ai][0][m][1]), "+v"(acc[ai][1][m][0]), "+v"(acc[ai][1][m][1]));
                if (m & 1) asm volatile("" ::: "memory"); }
        const bool bad1 = bad;
        bad = st2.run(acc, u, wr, wc, fr, fq, lds, wid, lane) || bad;
#pragma unroll
        for (int ai = 0; ai < 2; ++ai)
#pragma unroll
            for (int m = 0; m < 4; ++m) { const int r = ai * HALF + wr * 64 + m * 16 + fr; const f32x2v sr = S[r]; const size_t off = (size_t)(u.pm * BM + r) * ldc + col0;
#pragma unroll
                for (int bj = 0; bj < 2; ++bj)
#pragma unroll
                    for (int n = 0; n < 2; ++n) { const f32x4 x1 = acc[ai][bj][m][n]; *(f32x4*)(out + off + bj * HALF + n * 16) = bad1 ? (f32x4){qnan, qnan, qnan, qnan} : x1;
                        const f32x4 o = (x1 - sr.x) * sr.y; u32x2v w; w.x = cvt_pk_bf16(o[0], o[1]); w.y = cvt_pk_bf16(o[2], o[3]);
                        if (bad) { w.x = 0x7fc07fc0u; w.y = 0x7fc07fc0u; } *(u32x2v*)(xn + off + bj * HALF + n * 16) = w; }
                asm volatile("" ::: "memory"); }
    }
};

template <class Epi, class Sched, bool ALIGN_EPI = false, bool SP2 = false>
__device__ __forceinline__ void gemm_phase(PG8_LAS unsigned char* lds, const Gemm g, const Sched& S, const Epi& E) {
    int tid_ = threadIdx.x; asm volatile("" : "+v"(tid_));
    const int tid = tid_, wid = __builtin_amdgcn_readfirstlane(tid >> 6), lane = tid & 63, wr = wid >> 2, wc = wid & 3, fr = lane & 15, fq = lane >> 4;
    const int K = g.K, nt = K / BK;
    unsigned voffA[2], voffB[2];
#pragma unroll
    for (int i = 0; i < 2; ++i) { int R, C; stage_rc(tid * 16 + i * 8192, R, C); const int Rb = Epi::PERM ? ((R & ~31) + perm32(R & 31)) : R;
        voffA[i] = (unsigned)(R * K + C) * 2u; voffB[i] = (unsigned)(Rb * K + C) * 2u; }
    const size_t kstep = (size_t)(BK * 2);
    const size_t hstep = (size_t)HALF * K * 2;
    const size_t tstep = 2 * hstep;
    const unsigned ldsw = (unsigned)wid * 1024u;
    const int aoff = lds_byte(wr * 64 + fr, fq * 8), boff = lds_byte(wc * 32 + fr, fq * 8);
#define PG8_SA(b, h) (((b) * 2 + (h)) * HTB)
#define PG8_SB(b, h) ((4 + (b) * 2 + (h)) * HTB)
#define PG8_STAGE(bufoff, gbase, voff) do { _Pragma("unroll") for (int _i = 0; _i < 2; ++_i) \
        __builtin_amdgcn_global_load_lds((const unsigned*)((const char*)(gbase) + (voff)[_i]), (PG8_LAS unsigned*)(lds + (bufoff) + ldsw + _i * 8192), 16, 0, 0); } while (0)
#define PG8_LDA(dst, b, h) do { _Pragma("unroll") for (int m = 0; m < 4; ++m) _Pragma("unroll") for (int k = 0; k < 2; ++k) dst[m][k] = *(const PG8_LAS bf16x8*)(lds + PG8_SA(b, h) + aoff + m * 2048 + k * 1024); } while (0)
#define PG8_LDB(dst, b, h) do { _Pragma("unroll") for (int n = 0; n < 2; ++n) _Pragma("unroll") for (int k = 0; k < 2; ++k) dst[n][k] = *(const PG8_LAS bf16x8*)(lds + PG8_SB(b, h) + boff + n * 2048 + k * 1024); } while (0)
#define PG8_MMA(ai, bj, At, Bt) do { __builtin_amdgcn_s_setprio(1); _Pragma("unroll") for (int m = 0; m < 4; ++m) _Pragma("unroll") for (int n = 0; n < 2; ++n) _Pragma("unroll") for (int k = 0; k < 2; ++k) \
        acc[ai][bj][m][n] = __builtin_amdgcn_mfma_f32_16x16x32_bf16(Bt[n][k], At[m][k], acc[ai][bj][m][n], 0, 0, 0); __builtin_amdgcn_s_setprio(0); } while (0)
#define PG8_WAIT_V(n) asm volatile("s_waitcnt vmcnt(" #n ")" ::: "memory")
#define PG8_WAIT_L(n) asm volatile("s_waitcnt lgkmcnt(" #n ")" ::: "memory")
#define PG8_BAR __builtin_amdgcn_s_barrier()
#define PG8_SCHED __builtin_amdgcn_sched_barrier(0)
    Unit cur, nxt; int ui = 0;
    if (!S.next(0, cur)) return;
    f32x4 acc[2][2][4][2];
#pragma unroll
    for (int a = 0; a < 2; ++a)
#pragma unroll
        for (int b = 0; b < 2; ++b)
#pragma unroll
            for (int m = 0; m < 4; ++m)
#pragma unroll
                for (int n = 0; n < 2; ++n) acc[a][b][m][n] = (f32x4){0.f, 0.f, 0.f, 0.f};
    bf16x8 At[4][2], B0[2][2], B1[2][2];
    const char* cA = (const char*)g.A + (size_t)cur.pm * tstep; const char* cB = (const char*)g.Bt + (size_t)cur.pn * tstep;
    S.a_ready(cur);
    if constexpr (SP2) {
        PG8_STAGE(PG8_SB(0, 0), cB, voffB); PG8_STAGE(PG8_SB(0, 1), cB + hstep, voffB); PG8_STAGE(PG8_SA(0, 0), cA, voffA); PG8_STAGE(PG8_SA(0, 1), cA + hstep, voffA);
        if (wr == 1) PG8_BAR;
        PG8_WAIT_V(2); PG8_BAR;
        PG8_STAGE(PG8_SB(1, 0), cB + kstep, voffB); PG8_STAGE(PG8_SA(1, 0), cA + kstep, voffA); PG8_STAGE(PG8_SB(1, 1), cB + hstep + kstep, voffB);
        PG8_WAIT_V(6); PG8_BAR;
    } else {
        PG8_STAGE(PG8_SB(0, 0), cB, voffB); PG8_STAGE(PG8_SA(0, 0), cA, voffA); PG8_STAGE(PG8_SB(0, 1), cB + hstep, voffB); PG8_STAGE(PG8_SA(0, 1), cA + hstep, voffA);
        if (wr == 1) PG8_BAR;
        PG8_WAIT_V(4); PG8_BAR;
        PG8_STAGE(PG8_SB(1, 0), cB + kstep, voffB); PG8_STAGE(PG8_SA(1, 0), cA + kstep, voffA); PG8_STAGE(PG8_SB(1, 1), cB + hstep + kstep, voffB);
        PG8_WAIT_V(6); PG8_BAR;
    }
    for (;;) {
        const bool has_next = S.next(ui + 1, nxt);
        const char* nA = has_next ? (const char*)g.A + (size_t)nxt.pm * tstep : cA; const char* nB = has_next ? (const char*)g.Bt + (size_t)nxt.pn * tstep : cB;
        for (int t = 0; t < nt; t += 2) {
            const bool last = (t == nt - 2);
            const char* a1 = cA + (size_t)(t + 1) * kstep;
            const char* a2 = last ? nA : cA + (size_t)(t + 2) * kstep; const char* b2 = last ? nB : cB + (size_t)(t + 2) * kstep;
            const char* a3 = a2 + kstep; const char* b3 = b2 + kstep;
            if (last && has_next) S.a_ready(nxt);
            if constexpr (SP2) {
            PG8_LDB(B0, 0, 0); PG8_LDB(B1, 0, 1); PG8_SCHED; PG8_LDA(At, 0, 0); PG8_STAGE(PG8_SA(1, 1), a1 + hstep, voffA);
            PG8_WAIT_V(8); PG8_WAIT_L(0); PG8_BAR; PG8_MMA(0, 0, At, B0); PG8_MMA(0, 1, At, B1); PG8_BAR; PG8_SCHED;
            PG8_LDA(At, 0, 1); PG8_STAGE(PG8_SB(0, 0), b2, voffB); PG8_STAGE(PG8_SB(0, 1), b2 + hstep, voffB); PG8_STAGE(PG8_SA(0, 0), a2, voffA);
            PG8_WAIT_V(8); PG8_WAIT_L(0); PG8_BAR; PG8_MMA(1, 0, At, B0); PG8_MMA(1, 1, At, B1); PG8_BAR; PG8_SCHED;
            PG8_LDB(B0, 1, 0); PG8_LDB(B1, 1, 1); PG8_SCHED; PG8_LDA(At, 1, 0); PG8_STAGE(PG8_SA(0, 1), a2 + hstep, voffA);
            PG8_WAIT_V(8); PG8_WAIT_L(0); PG8_BAR; PG8_MMA(0, 0, At, B0); PG8_MMA(0, 1, At, B1); PG8_BAR; PG8_SCHED;
            PG8_LDA(At, 1, 1); PG8_STAGE(PG8_SB(1, 0), b3, voffB); PG8_STAGE(PG8_SB(1, 1), b3 + hstep, voffB); PG8_STAGE(PG8_SA(1, 0), a3, voffA);
            PG8_WAIT_V(8); PG8_WAIT_L(0); PG8_BAR; PG8_MMA(1, 0, At, B0); PG8_MMA(1, 1, At, B1); PG8_BAR; PG8_SCHED;
            } else {
            PG8_LDB(B0, 0, 0); PG8_SCHED; PG8_LDA(At, 0, 0); PG8_STAGE(PG8_SA(1, 1), a1 + hstep, voffA);
            PG8_WAIT_L(8); PG8_BAR; PG8_WAIT_L(0); PG8_MMA(0, 0, At, B0); PG8_BAR; PG8_SCHED;
            PG8_LDB(B1, 0, 1); PG8_STAGE(PG8_SB(0, 0), b2, voffB);
            PG8_BAR; PG8_WAIT_L(0); PG8_MMA(0, 1, At, B1); PG8_BAR;
            PG8_LDA(At, 0, 1); PG8_STAGE(PG8_SA(0, 0), a2, voffA);
            PG8_BAR; PG8_WAIT_L(0); PG8_MMA(1, 0, At, B0); PG8_BAR; PG8_SCHED;
            PG8_STAGE(PG8_SB(0, 1), b2 + hstep, voffB);
            PG8_WAIT_V(6); PG8_BAR; PG8_MMA(1, 1, At, B1); PG8_BAR;
            PG8_LDB(B0, 1, 0); PG8_SCHED; PG8_LDA(At, 1, 0); PG8_STAGE(PG8_SA(0, 1), a2 + hstep, voffA);
            PG8_WAIT_L(8); PG8_BAR; PG8_WAIT_L(0); PG8_MMA(0, 0, At, B0); PG8_BAR; PG8_SCHED;
            PG8_LDB(B1, 1, 1); PG8_STAGE(PG8_SB(1, 0), b3, voffB);
            PG8_BAR; PG8_WAIT_L(0); PG8_MMA(0, 1, At, B1); PG8_BAR;
            PG8_LDA(At, 1, 1); PG8_STAGE(PG8_SA(1, 0), a3, voffA);
            PG8_BAR; PG8_WAIT_L(0); PG8_MMA(1, 0, At, B0); PG8_BAR; PG8_SCHED;
            PG8_STAGE(PG8_SB(1, 1), b3 + hstep, voffB);
            PG8_WAIT_V(6); PG8_BAR; PG8_MMA(1, 1, At, B1); PG8_BAR;
            }
        }
        if constexpr (ALIGN_EPI) { if (wr == 0) PG8_BAR; }
        if constexpr (!Epi::AFTER_DRAIN) { E(acc, cur, wr, wc, fr, fq); S.done(cur); }
        if (!has_next) break;
#pragma unroll
        for (int a = 0; a < 2; ++a)
#pragma unroll
            for (int b = 0; b < 2; ++b)
#pragma unroll
                for (int m = 0; m < 4; ++m)
#pragma unroll
                    for (int n = 0; n < 2; ++n) acc[a][b][m][n] = (f32x4){0.f, 0.f, 0.f, 0.f};
        cur = nxt; cA = nA; cB = nB; ++ui;
        if constexpr (ALIGN_EPI) { if (wr == 1) PG8_BAR; }
    }
    PG8_WAIT_V(0);
    if constexpr (!ALIGN_EPI) { if (wr == 0) PG8_BAR; }
    PG8_BAR;
    if constexpr (Epi::AFTER_DRAIN) { E.fused(acc, cur, wr, wc, fr, fq, lds, wid, lane); S.done(cur); }
#undef PG8_SA
#undef PG8_SB
#undef PG8_STAGE
#undef PG8_LDA
#undef PG8_LDB
#undef PG8_MMA
#undef PG8_WAIT_V
#undef PG8_WAIT_L
#undef PG8_BAR
#undef PG8_SCHED
}
}
namespace pg8 {
template <int ACT> struct EpiB16 {
    static constexpr bool PERM = true, AFTER_DRAIN = false;
    bf16_t* O; int ldc; int split_cols; size_t split_stride;
    __device__ __forceinline__ void operator()(const f32x4 (&acc)[2][2][4][2], const Unit& u, int wr, int wc, int fr, int fq) const {
        const int row0 = u.pm * BM + wr * 64 + fr; int colt = u.pn * BM; bf16_t* base = O;
        if (split_cols) { const int t = colt / split_cols; base += (size_t)t * split_stride; colt -= t * split_cols; }
        const int col0 = colt + wc * 32 + 8 * fq;
#pragma unroll
        for (int ai = 0; ai < 2; ++ai)
#pragma unroll
            for (int m = 0; m < 4; ++m) { bf16_t* rowp = base + (size_t)(row0 + ai * HALF + m * 16) * ldc + col0;
#pragma unroll
                for (int bj = 0; bj < 2; ++bj) { f32x4 v0 = acc[ai][bj][m][0], v1 = acc[ai][bj][m][1];
                    if (ACT == 2) {
#pragma unroll
                        for (int e = 0; e < 4; ++e) { float a = fmaxf(v0[e], 0.f), b = fmaxf(v1[e], 0.f); v0[e] = a * a; v1[e] = b * b; } }
                    u32x4 w; w.x = cvt_pk_bf16(v0[0], v0[1]); w.y = cvt_pk_bf16(v0[2], v0[3]); w.z = cvt_pk_bf16(v1[0], v1[1]); w.w = cvt_pk_bf16(v1[2], v1[3]);
                    *(u32x4*)(rowp + bj * HALF) = w; } }
    }
};
struct EpiF32 {
    static constexpr bool PERM = false, AFTER_DRAIN = false;
    float* O; int ldc;
    __device__ __forceinline__ void operator()(const f32x4 (&acc)[2][2][4][2], const Unit& u, int wr, int wc, int fr, int fq) const {
        const int row0 = u.pm * BM + wr * 64 + fr, col0 = u.pn * BM + wc * 32 + 4 * fq;
#pragma unroll
        for (int ai = 0; ai < 2; ++ai)
#pragma unroll
            for (int m = 0; m < 4; ++m) { float* rowp = O + (size_t)(row0 + ai * HALF + m * 16) * ldc + col0;
#pragma unroll
                for (int bj = 0; bj < 2; ++bj)
#pragma unroll
                    for (int n = 0; n < 2; ++n) *(f32x4*)(rowp + bj * HALF + n * 16) = acc[ai][bj][m][n]; }
    }
};
struct EpiGate {
    static constexpr bool PERM = false, AFTER_DRAIN = false;
    const float* E; float* O; int ldc;
    __device__ __forceinline__ void operator()(const f32x4 (&acc)[2][2][4][2], const Unit& u, int wr, int wc, int fr, int fq) const {
        const int row0 = u.pm * BM + wr * 64 + fr, col0 = u.pn * BM + wc * 32 + 4 * fq;
#pragma unroll
        for (int ai = 0; ai < 2; ++ai)
#pragma unroll
            for (int m = 0; m < 4; ++m) { const size_t off = (size_t)(row0 + ai * HALF + m * 16) * ldc + col0;
#pragma unroll
                for (int bj = 0; bj < 2; ++bj)
#pragma unroll
                    for (int n = 0; n < 2; ++n) { const f32x4 e = *(const f32x4*)(E + off + bj * HALF + n * 16); const f32x4 a = acc[ai][bj][m][n]; f32x4 o;
#pragma unroll
                        for (int k = 0; k < 4; ++k) o[k] = e[k] * __builtin_amdgcn_rcpf(1.f + __expf(-a[k]));
                        *(f32x4*)(O + off + bj * HALF + n * 16) = o; } }
    }
};
struct EpiAttnIn {
    static constexpr bool PERM = true, AFTER_DRAIN = false;
    float* QK; bf16_t* V;
    __device__ __forceinline__ void operator()(const f32x4 (&acc)[2][2][4][2], const Unit& u, int wr, int wc, int fr, int fq) const {
        const int row0 = u.pm * BM + wr * 64 + fr;
        if (u.pn < 10) {
            const int col0 = u.pn * BM + wc * 32 + 8 * fq;
#pragma unroll
            for (int ai = 0; ai < 2; ++ai)
#pragma unroll
                for (int m = 0; m < 4; ++m) { float* rowp = QK + (size_t)(row0 + ai * HALF + m * 16) * 2560 + col0;
#pragma unroll
                    for (int bj = 0; bj < 2; ++bj) { *(f32x4*)(rowp + bj * HALF) = acc[ai][bj][m][0]; *(f32x4*)(rowp + bj * HALF + 4) = acc[ai][bj][m][1]; } }
        } else {
            const int col0 = (u.pn - 10) * BM + wc * 32 + 8 * fq;
#pragma unroll
            for (int ai = 0; ai < 2; ++ai)
#pragma unroll
                for (int m = 0; m < 4; ++m) { bf16_t* rowp = V + (size_t)(row0 + ai * HALF + m * 16) * 512 + col0;
#pragma unroll
                    for (int bj = 0; bj < 2; ++bj) { const f32x4 v0 = acc[ai][bj][m][0], v1 = acc[ai][bj][m][1];
                        u32x4 w; w.x = cvt_pk_bf16(v0[0], v0[1]); w.y = cvt_pk_bf16(v0[2], v0[3]); w.z = cvt_pk_bf16(v1[0], v1[1]); w.w = cvt_pk_bf16(v1[2], v1[3]);
                        *(u32x4*)(rowp + bj * HALF) = w; } }
        }
    }
};
}
#define GAS __attribute__((address_space(1)))
#define LAS __attribute__((address_space(3)))
typedef unsigned short bf16;
typedef unsigned v4u __attribute__((ext_vector_type(4)));
typedef float f32x4 __attribute__((ext_vector_type(4)));
typedef short bf16x8 __attribute__((ext_vector_type(8)));
typedef GAS unsigned gu32;
typedef GAS unsigned long long gu64;
#define RLX_AGENT __ATOMIC_RELAXED, __HIP_MEMORY_SCOPE_AGENT
#define LDS_WAIT() asm volatile("s_waitcnt lgkmcnt(0)" ::: "memory")
#define VM_WAIT() asm volatile("s_waitcnt vmcnt(0)" ::: "memory")
__device__ __forceinline__ unsigned long long rt() { return __builtin_amdgcn_s_memrealtime(); }
__device__ __forceinline__ unsigned f2bf(float f) { unsigned u = __builtin_bit_cast(unsigned, f); return (u + 0x7fffu + ((u >> 16) & 1u)) >> 16; }
__device__ __forceinline__ unsigned pk2(float lo, float hi) { return f2bf(lo) | (f2bf(hi) << 16); }

#define XB_TMO      128
#define XB_XCNT(j)  (256  + 64 * (j))
#define XB_XSUB(j)  (1280 + 64 * (j))
#define XB_XGEN(j)  (2304 + 64 * (j))
#define XB_TOP      3328
#define XB_TOPGEN   3392
#define XCD_BAR_WORDS 3456
#define XB_SPIN_CAP (1u << 18)

__device__ __forceinline__ unsigned xb_ld(unsigned* p)              { return __hip_atomic_load(p, __ATOMIC_RELAXED, __HIP_MEMORY_SCOPE_AGENT); }
__device__ __forceinline__ unsigned xb_add(unsigned* p, unsigned v) { return __hip_atomic_fetch_add(p, v, __ATOMIC_RELAXED, __HIP_MEMORY_SCOPE_AGENT); }
__device__ __forceinline__ unsigned xb_xcc_id() { return (unsigned)__builtin_amdgcn_s_getreg((3 << 11) | 20) & 0xFu; }
#define XB_SPIN(cond, bar) do { unsigned _sp = 0; while (cond) { __builtin_amdgcn_s_sleep(1); \
    if ((++_sp & 255u) == 0u) { if (xb_ld(&(bar)[XB_TMO])) break; if (_sp > XB_SPIN_CAP) { atomicAdd(&(bar)[XB_TMO], 1u); break; } } } } while (0)

struct XcdBarrier {
    unsigned* bar; unsigned x;
    volatile LAS unsigned* st;
};

__device__ __forceinline__ XcdBarrier xcd_barrier_post(unsigned* bar, volatile LAS unsigned* st) {
    XcdBarrier b; b.bar = bar; b.x = xb_xcc_id(); b.st = st;
    if (threadIdx.x == 0) (void)xb_add(&bar[XB_XCNT(b.x)], 1u);
    return b;
}
__device__ __forceinline__ void xcd_barrier_complete(unsigned* bar, unsigned x, unsigned& nloc, unsigned& nx) {
    const unsigned G = gridDim.x * gridDim.y * gridDim.z;
    unsigned sum, cnt, mine, sp = 0u;
    for (;;) {
        sum = 0u; cnt = 0u; mine = 0u;
#pragma unroll
        for (unsigned j = 0; j < 16; ++j) { const unsigned c = xb_ld(&bar[XB_XCNT(j)]); sum += c; cnt += (c > 0u) ? 1u : 0u; mine = (j == x) ? c : mine; }
        if (sum == G) break;
        __builtin_amdgcn_s_sleep(1);
        if ((++sp & 255u) == 0u) { if (xb_ld(&bar[XB_TMO])) break; if (sp > XB_SPIN_CAP) { atomicAdd(&bar[XB_TMO], 1u); break; } }
    }
    nloc = mine > 0u ? mine : 1u; nx = cnt > 0u ? cnt : 1u;
}

__device__ __forceinline__ void xcd_barrier(const XcdBarrier& b) {
    asm volatile("s_waitcnt vmcnt(0)" ::: "memory");
    __syncthreads();
    if (threadIdx.x == 0) {
        unsigned* bar = b.bar;
        __builtin_amdgcn_s_waitcnt(0);
        unsigned nloc = b.st[0], nx = b.st[1];
        if (nloc == 0u) { xcd_barrier_complete(bar, b.x, nloc, nx); b.st[0] = nloc; b.st[1] = nx; }
        const unsigned old = xb_add(&bar[XB_XSUB(b.x)], 1u);
        const unsigned gen = old / nloc;
        if (old + 1u == (gen + 1u) * nloc) {
            __builtin_amdgcn_fence(__ATOMIC_RELEASE, "agent");
            asm volatile("s_waitcnt vmcnt(0)" ::: "memory");
            const unsigned og = xb_add(&bar[XB_TOP], 1u);
            const unsigned tg = og / nx;
            if (og + 1u == (tg + 1u) * nx) xb_add(&bar[XB_TOPGEN], 1u);
            else XB_SPIN(xb_ld(&bar[XB_TOPGEN]) == tg, bar);
            __builtin_amdgcn_fence(__ATOMIC_ACQUIRE, "agent");
            xb_add(&bar[XB_XGEN(b.x)], 1u);
            asm volatile("s_waitcnt vmcnt(0)" ::: "memory");
        } else {
            XB_SPIN(xb_ld(&bar[XB_XGEN(b.x)]) == gen, bar);
            __builtin_amdgcn_fence(__ATOMIC_ACQUIRE, "agent");
            asm volatile("s_waitcnt vmcnt(0)" ::: "memory");
        }
    }
    __syncthreads();
}
namespace fk {
constexpr int NWAVES = 8;
constexpr int L = 8192, DM = 2048, DFF = 8192, PLED = 256, GIN = 6176, GMAIN = 6144, AIN = 3072;
constexpr float EPS = 1e-6f;
constexpr size_t MiB = 1u << 20;
constexpr size_t WS_CTL = 0, CTL_ZERO_BYTES = 256 * 1024;
constexpr size_t WS_W_GLA_IN = 1 * MiB, WS_W_GLA_OUT = 26 * MiB, WS_W_ATT_IN = 34 * MiB, WS_W_ATT_OUT = 46 * MiB;
constexpr size_t WS_W_UP = 54 * MiB, WS_W_DOWN = 118 * MiB, WS_W_GATE = 182 * MiB, WS_W_PROJ = 198 * MiB, WS_PBF = 200 * MiB;
constexpr size_t WS_U = 208 * MiB, WS_T = 240 * MiB, WS_HID = 304 * MiB, WS_E = 432 * MiB, WS_END = 496 * MiB;
constexpr size_t WS_QK = 304 * MiB, WS_V = 336 * MiB, WS_OG = 368 * MiB, WS_QD = 400 * MiB  , WS_OF = 464 * MiB;
constexpr size_t WS_OB = 240 * MiB, WS_LR = 272 * MiB, WS_DEC = 273 * MiB, WS_PM = 274 * MiB;
constexpr size_t WS_AQK = 304 * MiB, WS_AV = 384 * MiB, WS_AK = 392 * MiB, WS_AQ = 400 * MiB;
constexpr int CW_BAR = 4096;
constexpr size_t WS_ROPE = 512 * 1024;
constexpr int RING_OFF = 0, RING_BYTES = 131072, LDSCTL_OFF = RING_BYTES, MISC_OFF = LDSCTL_OFF + 320, LDS_BYTES = 147456;

struct Args { const float* in[22]; float* out; unsigned char* ws; const float* pre_src; const float* pre_gain; int ph_lo, ph_hi, pre, bar_region; };
enum { I_X = 0, I_P, I_G_PRE_MIX, I_G_POST_MIX, I_G_PRE_MLP, I_G_POST_MLP, I_G_PLE, I_W_UP, I_W_DOWN, I_W_PLE_PROJ, I_W_PLE_GATE, I_GLA_W_IN, I_GLA_WGK_F, I_GLA_BGK_F,
       I_GLA_WGK_B, I_GLA_BGK_B, I_GLA_G_HEAD, I_GLA_W_OUT, I_ATT_W_IN, I_ATT_GQ, I_ATT_GK, I_ATT_W_OUT };

__device__ __forceinline__ float wave_sum(float v) {
#pragma unroll
    for (int o = 1; o < 64; o <<= 1) v += __shfl_xor(v, o);
    return v;
}
__device__ __forceinline__ void p0_transpose_item(const float* W, int K, int N, bf16* WT, LAS float* scr, int item, int lane) {
    const int nblk = N / 32, kb = item / nblk, nb = item % nblk, k0 = 64 * kb, n0 = 32 * nb;
#pragma unroll 8
    for (int i = 0; i < 32; ++i) { const int kk = 2 * i + (lane >> 5); scr[kk * 33 + (lane & 31)] = W[(size_t)(k0 + kk) * N + n0 + (lane & 31)]; }
    LDS_WAIT(); asm volatile("" ::: "memory");
    const int c = lane & 7;
#pragma unroll
    for (int j = 0; j < 4; ++j) { const int n = (lane >> 3) + 8 * j; const LAS float* s = scr + (8 * c) * 33 + n;
        v4u o; o.x = pk2(s[0 * 33], s[1 * 33]); o.y = pk2(s[2 * 33], s[3 * 33]); o.z = pk2(s[4 * 33], s[5 * 33]); o.w = pk2(s[6 * 33], s[7 * 33]);
        *(GAS v4u*)(WT + (size_t)(n0 + n) * K + k0 + 8 * c) = o; }
    LDS_WAIT(); asm volatile("" ::: "memory");
}
__device__ __forceinline__ void row_op(const float* hin, const float* t, const float* g_post, float* hout, const float* g_pre, bf16* U, int umode, size_t row, int lane) {
    const size_t base = row * DM + 8 * lane;
    f32x4 h[4][2];
    if (t) {
        f32x4 tv[4][2]; float ss = 0.f;
#pragma unroll
        for (int j = 0; j < 4; ++j)
#pragma unroll
            for (int q = 0; q < 2; ++q) { tv[j][q] = *(const GAS f32x4*)(t + base + 512 * j + 4 * q); ss += (tv[j][q].x * tv[j][q].x + tv[j][q].y * tv[j][q].y) + (tv[j][q].z * tv[j][q].z + tv[j][q].w * tv[j][q].w); }
        const float rs = rsqrtf(wave_sum(ss) * (1.f / DM) + EPS);
#pragma unroll
        for (int j = 0; j < 4; ++j)
#pragma unroll
            for (int q = 0; q < 2; ++q) { const f32x4 g = *(const GAS f32x4*)(g_post + 8 * lane + 512 * j + 4 * q); const f32x4 hi = *(const GAS f32x4*)(hin + base + 512 * j + 4 * q);
                h[j][q] = hi + tv[j][q] * rs * g; *(GAS f32x4*)(hout + base + 512 * j + 4 * q) = h[j][q]; }
    } else {
#pragma unroll
        for (int j = 0; j < 4; ++j)
#pragma unroll
            for (int q = 0; q < 2; ++q) h[j][q] = *(const GAS f32x4*)(hin + base + 512 * j + 4 * q);
    }
    if (umode == 0) return;
    float rs2 = 1.f;
    if (umode == 1) { float ss = 0.f;
#pragma unroll
        for (int j = 0; j < 4; ++j)
#pragma unroll
            for (int q = 0; q < 2; ++q) ss += (h[j][q].x * h[j][q].x + h[j][q].y * h[j][q].y) + (h[j][q].z * h[j][q].z + h[j][q].w * h[j][q].w);
        rs2 = rsqrtf(wave_sum(ss) * (1.f / DM) + EPS); }
#pragma unroll
    for (int j = 0; j < 4; ++j) { f32x4 a = h[j][0] * rs2, b = h[j][1] * rs2;
        if (umode == 1) { a = a * *(const GAS f32x4*)(g_pre + 8 * lane + 512 * j); b = b * *(const GAS f32x4*)(g_pre + 8 * lane + 512 * j + 4); }
        v4u o; o.x = pk2(a.x, a.y); o.y = pk2(a.z, a.w); o.z = pk2(b.x, b.y); o.w = pk2(b.z, b.w);
        *(GAS v4u*)(U + base + 512 * j) = o; }
}
}
namespace fk {
typedef float f32x4v __attribute__((ext_vector_type(4)));
typedef short s16x8 __attribute__((ext_vector_type(8)));
typedef short s16x4 __attribute__((ext_vector_type(4)));
typedef float f32x2v __attribute__((ext_vector_type(2)));
typedef unsigned u32x2v __attribute__((ext_vector_type(2)));
__device__ __forceinline__ float bf2f(unsigned short b) { return __builtin_bit_cast(float, (unsigned)b << 16); }
__device__ __forceinline__ float logsig(float z) { return fminf(z, 0.f) - __logf(1.f + __expf(-fabsf(z))); }

__device__ __forceinline__ void gla_lr_rows(const bf16* U, const bf16* Wlr  , float* LR, int r0, LAS unsigned char* lds, int tid) {
    const int lane = tid & 63, w = __builtin_amdgcn_readfirstlane(tid >> 6), fr = lane & 15, fq = lane >> 4;
    f32x4v acc[2][2];
#pragma unroll
    for (int m = 0; m < 2; ++m)
#pragma unroll
        for (int n = 0; n < 2; ++n) acc[m][n] = (f32x4v){0.f, 0.f, 0.f, 0.f};
#pragma unroll 2
    for (int ks = 0; ks < 8; ++ks) {
        const int k = w * 256 + ks * 32 + fq * 8;
        s16x8 af[2], bfv[2];
#pragma unroll
        for (int m = 0; m < 2; ++m) af[m] = *(const GAS s16x8*)(U + (size_t)(r0 + 16 * m + fr) * DM + k);
#pragma unroll
        for (int n = 0; n < 2; ++n) bfv[n] = *(const GAS s16x8*)(Wlr + (size_t)(16 * n + fr) * DM + k);
#pragma unroll
        for (int m = 0; m < 2; ++m)
#pragma unroll
            for (int n = 0; n < 2; ++n) acc[m][n] = __builtin_amdgcn_mfma_f32_16x16x32_bf16(af[m], bfv[n], acc[m][n], 0, 0, 0);
    }
    LAS float* red = (LAS float*)lds;
#pragma unroll
    for (int m = 0; m < 2; ++m)
#pragma unroll
        for (int n = 0; n < 2; ++n)
#pragma unroll
            for (int r = 0; r < 4; ++r) red[w * 1024 + (16 * m + 4 * fq + r) * 32 + 16 * n + fr] = acc[m][n][r];
    __syncthreads();
#pragma unroll
    for (int i = 0; i < 2; ++i) { const int e = tid + 512 * i; float s = 0.f;
#pragma unroll
        for (int ww = 0; ww < 8; ++ww) s += red[ww * 1024 + e];
        LR[(size_t)r0 * 32 + e] = s; }
    __syncthreads();
}

__device__ __forceinline__ int sw_off(int row, int col) { return row * 512 + ((((col >> 3) ^ (row & 15)) << 4) | ((col & 7) << 1)); }

__device__ __forceinline__ void gla_prep_item(const Args& a, unsigned char* ws, int chunk, int hd, LAS unsigned char* lds, int tid) {
    const int lane = tid & 63, w = __builtin_amdgcn_readfirstlane(tid >> 6), fr = lane & 15, fq = lane >> 4;
    const int d = tid & 255, th = tid >> 8;
    const bf16* QK = (const bf16*)(ws + WS_QK); const float* LR = (const float*)(ws + WS_LR);
    LAS unsigned char* qs = lds; LAS unsigned char* ks = lds + 32768;
    LAS float* lrs = (LAS float*)(lds + 65536);
    LAS float* hs = (LAS float*)(lds + 65536 + 8192);
    { const f32x4 v = *(const GAS f32x4*)(LR + (size_t)chunk * 64 * 32 + tid * 4); *(LAS f32x4*)(lrs + tid * 4) = v; }
    __syncthreads();
    const int t0 = chunk * 64;
#pragma unroll 1
    for (int dir = 0; dir < 2; ++dir) {
        const float* wg = a.in[dir ? I_GLA_WGK_B : I_GLA_WGK_F]; const float* bg = a.in[dir ? I_GLA_BGK_B : I_GLA_BGK_F];
        float wcol[16];
#pragma unroll
        for (int r = 0; r < 16; ++r) wcol[r] = wg[r * 1024 + hd * 256 + d];
        const float bb = bg[hd * 256 + d];
        float run = 0.f;
#pragma unroll 2
        for (int tt = 0; tt < 32; ++tt) { const int t = th * 32 + tt; float z = bb;
#pragma unroll
            for (int r = 0; r < 16; ++r) z = fmaf(lrs[t * 32 + dir * 16 + r], wcol[r], z);
            run += logsig(z) * 0.0625f; }
        hs[(dir * 2 + th) * 256 + d] = run;
    }
    __syncthreads();
    f32x4v pf[2], pb[2];
#pragma unroll 1
    for (int dir = 0; dir < 2; ++dir) {
        const float* wg = a.in[dir ? I_GLA_WGK_B : I_GLA_WGK_F]; const float* bg = a.in[dir ? I_GLA_BGK_B : I_GLA_BGK_F];
        float wcol[16];
#pragma unroll
        for (int r = 0; r < 16; ++r) wcol[r] = wg[r * 1024 + hd * 256 + d];
        const float bb = bg[hd * 256 + d];
        const float h0 = hs[(dir * 2 + 0) * 256 + d], h1 = hs[(dir * 2 + 1) * 256 + d];
        const float total = h0 + h1, ref = h0;
        bf16* QD = (bf16*)(ws + WS_QD + (size_t)dir * 16 * MiB) + (size_t)t0 * 1024 + hd * 256 + d;
        bf16* KT = (bf16*)(ws + WS_QD + (size_t)(2 + dir) * 16 * MiB) + ((size_t)(chunk * 4 + hd) * 256 + d) * 64 + th * 32;
        if (th == 0) ((float*)(ws + WS_DEC))[(size_t)dir * 128 * 1024 + chunk * 1024 + hd * 256 + d] = __expf(total);
        float run = th ? h0 : 0.f;
#pragma unroll 1
        for (int g8 = 0; g8 < 4; ++g8) {
            unsigned ktw[4];
#pragma unroll
            for (int j = 0; j < 8; ++j) { const int t = th * 32 + g8 * 8 + j; float z = bb;
#pragma unroll
                for (int r = 0; r < 16; ++r) z = fmaf(lrs[t * 32 + dir * 16 + r], wcol[r], z);
                const float ex = run; run += logsig(z) * 0.0625f; const float pt = run;
                const float q = bf2f(QK[(size_t)(t0 + t) * DM + hd * 256 + d]) * 0.0625f, k = bf2f(QK[(size_t)(t0 + t) * DM + 1024 + hd * 256 + d]);
                float qd, kt, qsv, ksv;
                if (dir == 0) { qd = q * __expf(pt); kt = k * __expf(total - pt); qsv = q * __expf(pt - ref); ksv = k * __expf(ref - pt); }
                else          { qd = q * __expf(total - ex); kt = k * __expf(ex); qsv = q * __expf(ref - ex); ksv = k * __expf(ex - ref); }
                QD[(size_t)t * 1024] = (bf16)f2bf(qd);
                const int so = sw_off(t, d);
                *(LAS bf16*)(qs + so) = (bf16)f2bf(qsv); *(LAS bf16*)(ks + so) = (bf16)f2bf(ksv);
                const unsigned kb = f2bf(kt);
                if (j & 1) ktw[j >> 1] |= kb << 16; else ktw[j >> 1] = kb; }
            v4u o; o.x = ktw[0]; o.y = ktw[1]; o.z = ktw[2]; o.w = ktw[3]; *(GAS v4u*)(KT + g8 * 8) = o;
        }
        __syncthreads();
        f32x4v pt2[2] = {(f32x4v){0.f, 0.f, 0.f, 0.f}, (f32x4v){0.f, 0.f, 0.f, 0.f}};
        const int tt0 = 16 * (w & 3), st0 = 32 * (w >> 2);
#pragma unroll
        for (int kk = 0; kk < 8; ++kk) { const int col = kk * 32 + fq * 8;
            const s16x8 bq = *(const LAS s16x8*)(qs + sw_off(tt0 + fr, col));
#pragma unroll
            for (int i = 0; i < 2; ++i) { const s16x8 ak = *(const LAS s16x8*)(ks + sw_off(st0 + 16 * i + fr, col));
                pt2[i] = __builtin_amdgcn_mfma_f32_16x16x32_bf16(ak, bq, pt2[i], 0, 0, 0); } }
        if (dir == 0) { pf[0] = pt2[0]; pf[1] = pt2[1]; } else { pb[0] = pt2[0]; pb[1] = pt2[1]; }
        __syncthreads();
    }
    { bf16* PM = (bf16*)(ws + WS_PM) + (size_t)(hd * 128 + chunk) * 4096; const int t = 16 * (w & 3) + fr;
#pragma unroll
      for (int i = 0; i < 2; ++i) { const int s0 = 32 * (w >> 2) + 16 * i + 4 * fq; float v[4];
#pragma unroll
          for (int r = 0; r < 4; ++r) v[r] = (s0 + r <= t) ? pf[i][r] : pb[i][r];
          u32x2v o; o.x = pk2(v[0], v[1]); o.y = pk2(v[2], v[3]); *(GAS u32x2v*)(PM + t * 64 + s0) = o; } }
}

__device__ __forceinline__ void gla_scan_block(unsigned char* ws, int dir, int hd, int slice, LAS unsigned char* lds, int tid) {
    const int lane = tid & 63, w = __builtin_amdgcn_readfirstlane(tid >> 6), fr = lane & 15, fq = lane >> 4;
    const bf16* QD = (const bf16*)(ws + WS_QD + (size_t)dir * 16 * MiB) + hd * 256 + 32 * w + 4 * fq;
    const bf16* KT = (const bf16*)(ws + WS_QD + (size_t)(2 + dir) * 16 * MiB);
    const bf16* V = (const bf16*)(ws + WS_V) + hd * 512 + slice * 16;
    const bf16* PM = (const bf16*)(ws + WS_PM);
    const float* DEC = (const float*)(ws + WS_DEC) + (size_t)dir * 128 * 1024 + hd * 256 + 32 * w + 4 * fq;
    bf16* O = (bf16*)(ws + (dir ? WS_OB : WS_OF)) + hd * 512 + slice * 16;
    LAS float* red = (LAS float*)lds;
    LAS bf16* vT = (LAS bf16*)(lds + 65536);
    f32x4v S0 = (f32x4v){0.f, 0.f, 0.f, 0.f}, S1 = S0;
#pragma unroll 1
    for (int step = 0; step < 128; ++step) {
        const int n = dir ? 127 - step : step, buf = step & 1, tok0 = n * 64;
        if (tid < 128) { const int s = tid >> 1, e0 = (tid & 1) * 8; const s16x8 vv = *(const GAS s16x8*)(V + (size_t)(tok0 + s) * DM + e0);
#pragma unroll
            for (int j = 0; j < 8; ++j) vT[buf * 16 * 72 + (e0 + j) * 72 + s] = (bf16)vv[j]; }
        s16x4 qlo[4], qhi[4];
#pragma unroll
        for (int m = 0; m < 4; ++m) { const bf16* p = QD + (size_t)(tok0 + 16 * m + fr) * 1024; qlo[m] = *(const GAS s16x4*)p; qhi[m] = *(const GAS s16x4*)(p + 16); }
        s16x8 kf[2][2];
        { const bf16* kb = KT + ((size_t)(n * 4 + hd) * 256 + 32 * w + fr) * 64 + 8 * fq;
#pragma unroll
          for (int i = 0; i < 2; ++i)
#pragma unroll
              for (int ks2 = 0; ks2 < 2; ++ks2) kf[i][ks2] = *(const GAS s16x8*)(kb + (size_t)(16 * i) * 64 + 32 * ks2); }
        const f32x4 d0 = *(const GAS f32x4*)(DEC + (size_t)n * 1024), d1 = *(const GAS f32x4*)(DEC + (size_t)n * 1024 + 16);
        s16x8 pfrag;
        if (dir == 0) pfrag = *(const GAS s16x8*)(PM + (size_t)(hd * 128 + n) * 4096 + (16 * (w & 3) + fr) * 64 + 32 * (w >> 2) + 8 * fq);
        __syncthreads();
        s16x8 vf[2];
#pragma unroll
        for (int ks2 = 0; ks2 < 2; ++ks2) vf[ks2] = *(const LAS s16x8*)(vT + buf * 16 * 72 + fr * 72 + 32 * ks2 + 8 * fq);
        s16x8 sb; { const unsigned a0 = pk2(S0[0], S0[1]), a1 = pk2(S0[2], S0[3]), b0 = pk2(S1[0], S1[1]), b1 = pk2(S1[2], S1[3]); v4u t4; t4.x = a0; t4.y = a1; t4.z = b0; t4.w = b1; sb = __builtin_bit_cast(s16x8, t4); }
        f32x4v op[4];
#pragma unroll
        for (int m = 0; m < 4; ++m) { const s16x8 qf = (s16x8){qlo[m][0], qlo[m][1], qlo[m][2], qlo[m][3], qhi[m][0], qhi[m][1], qhi[m][2], qhi[m][3]};
            op[m] = __builtin_amdgcn_mfma_f32_16x16x32_bf16(sb, qf, (f32x4v){0.f, 0.f, 0.f, 0.f}, 0, 0, 0); }
        if (dir == 0) {
            const f32x4v oi = __builtin_amdgcn_mfma_f32_16x16x32_bf16((w >> 2) ? vf[1] : vf[0], pfrag, (f32x4v){0.f, 0.f, 0.f, 0.f}, 0, 0, 0);
            switch (w & 3) { case 0: op[0] += oi; break; case 1: op[1] += oi; break; case 2: op[2] += oi; break; default: op[3] += oi; break; }
        }
        S0 = S0 * d0; S1 = S1 * d1;
#pragma unroll
        for (int ks2 = 0; ks2 < 2; ++ks2) { S0 = __builtin_amdgcn_mfma_f32_16x16x32_bf16(kf[0][ks2], vf[ks2], S0, 0, 0, 0); S1 = __builtin_amdgcn_mfma_f32_16x16x32_bf16(kf[1][ks2], vf[ks2], S1, 0, 0, 0); }
#pragma unroll
        for (int m = 0; m < 4; ++m) *(LAS f32x4v*)(red + ((buf * 8 + w) * 64 + 16 * m + fr) * 16 + 4 * fq) = op[m];
        __syncthreads();
        { const int t = tid >> 3, e2 = (tid & 7) * 2; float s0 = 0.f, s1 = 0.f;
#pragma unroll
          for (int ww = 0; ww < 8; ++ww) { const f32x2v v2 = *(const LAS f32x2v*)(red + ((buf * 8 + ww) * 64 + t) * 16 + e2); s0 += v2.x; s1 += v2.y; }
          *(GAS unsigned*)(O + (size_t)(tok0 + t) * DM + e2) = pk2(s0, s1); }
    }
}

__device__ __forceinline__ void gla_gate_item(const Args& a, unsigned char* ws, int item, int lane) {
    const int t = item >> 2, hd = item & 3; const size_t off = (size_t)t * DM + hd * 512 + lane * 8;
    const s16x8 f = *(const GAS s16x8*)((const bf16*)(ws + WS_OF) + off), b = *(const GAS s16x8*)((const bf16*)(ws + WS_OB) + off), g = *(const GAS s16x8*)((const bf16*)(ws + WS_OG) + off);
    float o[8]; float ss = 0.f;
#pragma unroll
    for (int j = 0; j < 8; ++j) { o[j] = bf2f((unsigned short)f[j]) + bf2f((unsigned short)b[j]); ss += o[j] * o[j]; }
    const float rs = rsqrtf(wave_sum(ss) * (1.f / 512.f) + EPS);
    const f32x4 g0 = *(const GAS f32x4*)(a.in[I_GLA_G_HEAD] + lane * 8), g1 = *(const GAS f32x4*)(a.in[I_GLA_G_HEAD] + lane * 8 + 4);
    float r[8];
#pragma unroll
    for (int j = 0; j < 8; ++j) { const float og = bf2f((unsigned short)g[j]); const float gh = j < 4 ? g0[j & 3] : g1[j & 3]; r[j] = o[j] * rs * gh * (og * __builtin_amdgcn_rcpf(1.f + __expf(-og))); }
    v4u w; w.x = pk2(r[0], r[1]); w.y = pk2(r[2], r[3]); w.z = pk2(r[4], r[5]); w.w = pk2(r[6], r[7]);
    *(GAS v4u*)((bf16*)(ws + WS_U) + off) = w;
}
}
#define FK_GLA_PHASES \
        case 1: {     \
            pg8::Gemm g{U, (const bf16*)(ws + WS_W_GLA_IN), L, GMAIN, DM}; pg8::StaticOrder S; S.init(L, GMAIN, G, bx); \
            pg8::EpiB16<0> E{(bf16*)(ws + WS_QK), DM, DM, (size_t)L * DM}; \
            pg8::gemm_phase<pg8::EpiB16<0>, pg8::StaticOrder, true, true>(lds + RING_OFF, g, S, E); \
            for (int rb = bx; rb < L / 32; rb += G) gla_lr_rows(U, (const bf16*)(ws + WS_W_GLA_IN) + (size_t)GMAIN * DM, (float*)(ws + WS_LR), rb * 32, lds, tid); \
        } break; \
        case 2: { for (int it = bx; it < 512; it += G) { gla_prep_item(a, ws, it >> 2, it & 3, lds, tid); __syncthreads(); } } break; \
        case 3: { for (int b2 = bx; b2 < 256; b2 += G) { const int dh = b2 & 7; gla_scan_block(ws, dh >> 2, dh & 3, b2 >> 3, lds, tid); __syncthreads(); } } break; \
        case 4: { for (int it = gw; it < L * 4; it += NGW) gla_gate_item(a, ws, it, lane); } break;
namespace att {
using bf16 = __hip_bfloat16;
constexpr int   D = 128, NW = 8, QBLK = 32, KVBLK = 64;
constexpr float SCALE = 0.088388347648318440f;
constexpr float THR = 8.f;
constexpr int SDEPTH = 2;
constexpr int LDQ = 2048, LDK = 512, LDO = 2048;
constexpr size_t SHM_V = KVBLK * D * 2, SHM_K = KVBLK * D * 2, SHM_ATTN = 2 * SHM_V + 2 * SHM_K + NW * 64 * 4;
using bf16x8 = __attribute__((ext_vector_type(8))) short;
using s16x4  = __attribute__((ext_vector_type(4))) short;
using f32x16 = __attribute__((ext_vector_type(16))) float;
using f32x8  = __attribute__((ext_vector_type(8))) float;
using u32x4  = __attribute__((ext_vector_type(4))) unsigned;
#define KSWZ(row, colB) ((row) * 256 + ((colB) ^ (((row) & 7) << 4)))
#define SBAR() __builtin_amdgcn_sched_barrier(0)
__device__ __forceinline__ int crow(int r, int hi) { return (r & 3) + 8 * (r >> 2) + 4 * hi; }
__device__ __forceinline__ unsigned cvtpk(float lo, float hi) {
  unsigned r; asm volatile("v_cvt_pk_bf16_f32 %0, %1, %2" : "=v"(r) : "v"(lo), "v"(hi)); return r;
}
template <typename TIn> struct Stage;
template <> struct Stage<bf16>  { using T = bf16x8;
  __device__ static __forceinline__ T ld8(const bf16* p) { return *reinterpret_cast<const bf16x8*>(p); }
  __device__ static __forceinline__ bf16x8 tobf(T x) { return x; } };
template <> struct Stage<float> { using T = f32x8;
  __device__ static __forceinline__ T ld8(const float* p) { return *reinterpret_cast<const f32x8*>(p); }
  __device__ static __forceinline__ bf16x8 tobf(T x) {
    u32x4 w = {cvtpk(x[0], x[1]), cvtpk(x[2], x[3]), cvtpk(x[4], x[5]), cvtpk(x[6], x[7])}; return *reinterpret_cast<bf16x8*>(&w); } };

__device__ __forceinline__ void partialSM(f32x16& p0, f32x16& p1, float& m_reg, float& mn, float& alpha) {
  constexpr float C = SCALE * 1.4426950408889634f;
  float pmax = p0[0]; for (int r = 1; r < 16; ++r) pmax = fmaxf(pmax, p0[r]); for (int r = 0; r < 16; ++r) pmax = fmaxf(pmax, p1[r]);
  { auto rr = __builtin_amdgcn_permlane32_swap(__float_as_uint(pmax), __float_as_uint(pmax), false, false);
    pmax = fmaxf(__uint_as_float(rr[0]), __uint_as_float(rr[1])); }
  if (__builtin_expect(__all(pmax - m_reg <= THR / SCALE), 1)) { mn = m_reg; alpha = 1.f; }
  else { mn = fmaxf(m_reg, pmax); alpha = __builtin_amdgcn_exp2f((m_reg - mn) * C); m_reg = mn; }
  float mnC = -mn * C;
  for (int r = 0; r < 16; ++r) p0[r] = fmaf(p0[r], C, mnC); for (int r = 0; r < 16; ++r) p1[r] = fmaf(p1[r], C, mnC);
  for (int r = 0; r < 16; ++r) p0[r] = __builtin_amdgcn_exp2f(p0[r]);
}
__device__ __forceinline__ void finishSM(f32x16& p0, f32x16& p1, float alpha, float& l_reg, bf16x8& pa0, bf16x8& pa1, bf16x8& pa2, bf16x8& pa3) {
  for (int r = 0; r < 16; ++r) p1[r] = __builtin_amdgcn_exp2f(p1[r]);
  float ps = 0; for (int r = 0; r < 16; ++r) ps += p0[r]; for (int r = 0; r < 16; ++r) ps += p1[r];
  { auto rr = __builtin_amdgcn_permlane32_swap(__float_as_uint(ps), __float_as_uint(ps), false, false);
    ps = __uint_as_float(rr[0]) + __uint_as_float(rr[1]); }
  l_reg = l_reg * alpha + ps;
#define PK4(P, BASE, OUT) do { unsigned a0 = cvtpk(P[BASE + 0], P[BASE + 1]), a1 = cvtpk(P[BASE + 2], P[BASE + 3]);   \
    unsigned b0 = cvtpk(P[BASE + 4], P[BASE + 5]), b1 = cvtpk(P[BASE + 6], P[BASE + 7]);                              \
    auto r0 = __builtin_amdgcn_permlane32_swap(a0, b0, false, false); auto r1 = __builtin_amdgcn_permlane32_swap(a1, b1, false, false); \
    u32x4 w = {r0[0], r1[0], r0[1], r1[1]}; OUT = *reinterpret_cast<bf16x8*>(&w); } while (0)
  PK4(p0, 0, pa0); PK4(p0, 8, pa1); PK4(p1, 0, pa2); PK4(p1, 8, pa3);
#undef PK4
}
__device__ __forceinline__ void qkt(f32x16& p0, f32x16& p1, const bf16* Ks, const bf16x8* qr, int r32, int hi) {
  p0 = f32x16{}; p1 = f32x16{};
  for (int d0 = 0; d0 < 8; ++d0) { int cb = (d0 * 16 + hi * 8) * 2;
    bf16x8 b0 = *reinterpret_cast<const bf16x8*>((const char*)Ks + KSWZ(r32, cb));
    bf16x8 b1 = *reinterpret_cast<const bf16x8*>((const char*)Ks + KSWZ(32 + r32, cb));
    p0 = __builtin_amdgcn_mfma_f32_32x32x16_bf16(b0, qr[d0], p0, 0, 0, 0);
    p1 = __builtin_amdgcn_mfma_f32_32x32x16_bf16(b1, qr[d0], p1, 0, 0, 0); }
}
__device__ __forceinline__ int v_st(int k, int c) { const int kk = (k & ~0xC) | ((k & 4) << 1) | ((k & 8) >> 1); return ((kk >> 3) * 4 + (c >> 5)) * 512 + ((kk & 7) * 32 + (c & 31)) * 2; }
__device__ __forceinline__ int v_rd_base(int lane) { return ((lane & 3) << 3) | (((lane >> 2) & 3) << 6) | (((lane >> 4) & 1) << 5) | (((lane >> 5) & 1) << 8); }
constexpr int v_rd_off(int d0, int ks, int half) { return d0 * 512 + ks * 4096 + half * 2048; }
template <int OFF> __device__ __forceinline__ s16x4 tr_read(int vb) {
  s16x4 r; asm volatile("ds_read_b64_tr_b16 %0, %1 offset:%2" : "=&v"(r) : "v"(vb), "i"(OFF) : "memory"); return r;
}
template <int D0> __device__ __forceinline__ void pv_one(f32x16& od, int vb, bf16x8 pa0, bf16x8 pa1, bf16x8 pa2, bf16x8 pa3) {
  const s16x4 l0 = tr_read<v_rd_off(D0, 0, 0)>(vb), h0 = tr_read<v_rd_off(D0, 0, 1)>(vb), l1 = tr_read<v_rd_off(D0, 1, 0)>(vb), h1 = tr_read<v_rd_off(D0, 1, 1)>(vb);
  const s16x4 l2 = tr_read<v_rd_off(D0, 2, 0)>(vb), h2 = tr_read<v_rd_off(D0, 2, 1)>(vb), l3 = tr_read<v_rd_off(D0, 3, 0)>(vb), h3 = tr_read<v_rd_off(D0, 3, 1)>(vb);
  asm volatile("s_waitcnt lgkmcnt(0)" ::: "memory"); SBAR();
#define PK(L, H) (bf16x8){L[0], L[1], L[2], L[3], H[0], H[1], H[2], H[3]}
  od = __builtin_amdgcn_mfma_f32_32x32x16_bf16(pa0, PK(l0, h0), od, 0, 0, 0);
  od = __builtin_amdgcn_mfma_f32_32x32x16_bf16(pa1, PK(l1, h1), od, 0, 0, 0);
  od = __builtin_amdgcn_mfma_f32_32x32x16_bf16(pa2, PK(l2, h2), od, 0, 0, 0);
  od = __builtin_amdgcn_mfma_f32_32x32x16_bf16(pa3, PK(l3, h3), od, 0, 0, 0);
#undef PK
}
__device__ __forceinline__ void pv_d0(f32x16* o, int vb, bf16x8 pa0, bf16x8 pa1, bf16x8 pa2, bf16x8 pa3) {
  pv_one<0>(o[0], vb, pa0, pa1, pa2, pa3); pv_one<1>(o[1], vb, pa0, pa1, pa2, pa3); pv_one<2>(o[2], vb, pa0, pa1, pa2, pa3); pv_one<3>(o[3], vb, pa0, pa1, pa2, pa3);
}

template <typename TQ>
__device__ __forceinline__ void attn_dense_body(const TQ* __restrict__ Qb, const bf16* __restrict__ Kh, const bf16* __restrict__ Vh,
                                                unsigned short* __restrict__ Ob, int tok0, int seq, char* lds) {
  using St = Stage<bf16>; using SQ = Stage<TQ>;
  int tid_ = threadIdx.x; asm volatile("" : "+v"(tid_));
  const int tid = tid_, wid = tid >> 6, lane = tid & 63, r32 = lane & 31, hi = lane >> 5;
  bf16* V_lds = (bf16*)lds; bf16* K_lds = (bf16*)(lds + 2 * SHM_V);
  float* ws = (float*)(lds + 2 * SHM_V + 2 * SHM_K) + wid * 64; float* li_l = ws; float* al_l = ws + 32;
  float m_reg = -1e30f, l_reg = 0; f32x16 o[4] = {}; bf16x8 qr[8];
  const TQ* Qw = Qb + (long)(wid * QBLK + r32) * LDQ + hi * 8;
#pragma unroll
  for (int d0 = 0; d0 < 8; ++d0) qr[d0] = SQ::tobf(SQ::ld8(Qw + d0 * 16));
  const int sr = tid >> 4, sc = (tid & 15) * 8, vst0 = v_st(sr, sc), vst1 = v_st(32 + sr, sc);
  const int vb0 = (int)(uintptr_t)V_lds + v_rd_base(lane);
  struct { typename St::T vs0, vs1, ks0, ks1; } sr_[SDEPTH];
#define SLOAD(i, k0) do { sr_[i].vs0 = St::ld8(&Vh[(long)((k0) + sr) * LDK + sc]); sr_[i].vs1 = St::ld8(&Vh[(long)((k0) + 32 + sr) * LDK + sc]); \
    sr_[i].ks0 = St::ld8(&Kh[(long)((k0) + sr) * LDK + sc]); sr_[i].ks1 = St::ld8(&Kh[(long)((k0) + 32 + sr) * LDK + sc]); } while (0)
#define SWRITE(b, i) do { *(bf16x8*)((char*)V_lds + (b) * SHM_V + vst0) = St::tobf(sr_[i].vs0);          \
    *(bf16x8*)((char*)V_lds + (b) * SHM_V + vst1) = St::tobf(sr_[i].vs1); int kc = sc * 2;               \
    *(bf16x8*)((char*)K_lds + (b) * SHM_K + KSWZ(sr, kc)) = St::tobf(sr_[i].ks0);                       \
    *(bf16x8*)((char*)K_lds + (b) * SHM_K + KSWZ(32 + sr, kc)) = St::tobf(sr_[i].ks1); } while (0)
#define SWAIT() do { if constexpr (SDEPTH == 2) asm volatile("s_waitcnt vmcnt(4)" ::: "memory"); else asm volatile("s_waitcnt vmcnt(0)" ::: "memory"); } while (0)
#define RESC(a) do { if (__any((a) < 1.f)) { if (hi == 0) al_l[r32] = (a); asm volatile("s_waitcnt lgkmcnt(0)" ::: "memory"); \
    for (int d = 0; d < 4; ++d) for (int r = 0; r < 16; ++r) o[d][r] *= al_l[crow(r, hi)]; } } while (0)
  f32x16 pA0, pA1, pB0, pB1; float mnA, mnB, alA, alB; bf16x8 pa0, pa1, pa2, pa3; const int NT = seq / KVBLK;
  constexpr int SE = 0, SO = SDEPTH - 1;
  SLOAD(SE, 0); asm volatile("s_waitcnt vmcnt(0)" ::: "memory"); SWRITE(0, SE); __syncthreads();
  qkt(pA0, pA1, K_lds, qr, r32, hi); partialSM(pA0, pA1, m_reg, mnA, alA);
  SLOAD(SO, KVBLK); if constexpr (SDEPTH == 2) { if (2 < NT) SLOAD(SE, 2 * KVBLK); }
  SWAIT(); SWRITE(1, SO); __syncthreads();
  for (int j = 1; j + 1 < NT; j += 2) {
    SBAR(); qkt(pB0, pB1, (bf16*)((char*)K_lds + SHM_K), qr, r32, hi);
    finishSM(pA0, pA1, alA, l_reg, pa0, pa1, pa2, pa3); SBAR();
    SLOAD(SO, (j + SDEPTH) * KVBLK); SBAR();
    pv_d0(o, vb0, pa0, pa1, pa2, pa3); partialSM(pB0, pB1, m_reg, mnB, alB);
    __syncthreads(); SWAIT(); SWRITE(0, SE);
    RESC(alB); __syncthreads();
    SBAR(); qkt(pA0, pA1, K_lds, qr, r32, hi);
    finishSM(pB0, pB1, alB, l_reg, pa0, pa1, pa2, pa3); SBAR();
    if (SDEPTH == 1 || j + 3 < NT) SLOAD(SE, (j + 1 + SDEPTH) * KVBLK); SBAR();
    pv_d0(o, vb0 + (int)SHM_V, pa0, pa1, pa2, pa3); partialSM(pA0, pA1, m_reg, mnA, alA);
    __syncthreads(); SWAIT(); SWRITE(1, SO);
    RESC(alA); __syncthreads();
  }
  SBAR(); qkt(pB0, pB1, (bf16*)((char*)K_lds + SHM_K), qr, r32, hi);
  finishSM(pA0, pA1, alA, l_reg, pa0, pa1, pa2, pa3); SBAR();
  pv_d0(o, vb0, pa0, pa1, pa2, pa3); partialSM(pB0, pB1, m_reg, mnB, alB);
  __syncthreads(); RESC(alB);
  finishSM(pB0, pB1, alB, l_reg, pa0, pa1, pa2, pa3); SBAR();
  pv_d0(o, vb0 + (int)SHM_V, pa0, pa1, pa2, pa3);
  if (hi == 0) li_l[r32] = l_reg; asm volatile("s_waitcnt lgkmcnt(0)" ::: "memory");
  float rli[16];
#pragma unroll
  for (int r = 0; r < 16; ++r) rli[r] = __builtin_amdgcn_rcpf(li_l[crow(r, hi)]);
#pragma unroll
  for (int r = 0; r < 16; ++r) { const int t = tok0 + wid * QBLK + crow(r, hi); const long orow = (long)((t & 127) * 64 + (t >> 7));
    for (int d0 = 0; d0 < 4; ++d0) { const float v = o[d0][r] * rli[r]; unsigned u = __builtin_bit_cast(unsigned, v); u = (u + 0x7fffu + ((u >> 16) & 1u)) >> 16;
      Ob[orow * LDO + d0 * 32 + r32] = (unsigned short)u; } }
  __syncthreads();
#undef SLOAD
#undef SWRITE
#undef SWAIT
#undef RESC
}
}
#define FK_ATTN_PHASES         case 12: {     \
            pg8::Gemm g{U, (const bf16*)(ws + WS_W_ATT_IN), L, AIN, DM}; pg8::StaticOrder S; S.init(L, AIN, G, bx); \
            pg8::EpiAttnIn E{(float*)(ws + WS_AQK), (bf16*)(ws + WS_AV)}; \
            pg8::gemm_phase<pg8::EpiAttnIn, pg8::StaticOrder, true, true>(lds + RING_OFF, g, S, E); \
        } break; \
        case 13: {     \
            const float* QKf = (const float*)(ws + WS_AQK); bf16* Qb = (bf16*)(ws + WS_AQ); bf16* Kb = (bf16*)(ws + WS_AK); \
            const float2* tab = (const float2*)(ws + WS_ROPE); \
            const int hb = lane >> 5, j = lane & 31; \
            for (int item = gw; item < L * 20; item += NGW) { const int t = item / 20, hh = item - t * 20; \
                const float* src = QKf + (size_t)t * 2560 + hh * 128; const float v0 = src[lane], v1 = src[lane + 64]; \
                const float rs = rsqrtf(wave_sum(v0 * v0 + v1 * v1) * (1.f / 128.f) + EPS); \
                const float* gg = hh < 16 ? a.in[I_ATT_GQ] : a.in[I_ATT_GK]; \
                const float y0 = v0 * rs * gg[lane], y1 = v1 * rs * gg[lane + 64]; \
                const float2 cs0 = tab[(t >> 6) * 32 + j], cs1 = tab[(t & 63) * 32 + j]; \
                const float p0 = __shfl_xor(y0, 32), p1 = __shfl_xor(y1, 32); \
                const float o0 = hb == 0 ? (y0 * cs0.x - p0 * cs0.y) : (y0 * cs0.x + p0 * cs0.y); \
                const float o1 = hb == 0 ? (y1 * cs1.x - p1 * cs1.y) : (y1 * cs1.x + p1 * cs1.y); \
                bf16* dst = hh < 16 ? Qb + (size_t)t * 2048 + hh * 128 : Kb + (size_t)t * 512 + (hh - 16) * 128; \
                dst[lane] = (bf16)f2bf(o0); dst[lane + 64] = (bf16)f2bf(o1); } \
        } break; \
        case 14: {     \
            const att::bf16* Qb = (const att::bf16*)(ws + WS_AQ); const att::bf16* Kb = (const att::bf16*)(ws + WS_AK); const att::bf16* Vb = (const att::bf16*)(ws + WS_AV); \
            for (int i = 0;; ++i) { int h, qb; \
                if (G == 256) { if (i >= 2) break; const int xcd = bx & 7, slot = bx >> 3, uidx = (xcd & 1) * 64 + slot * 2 + i; h = (xcd >> 1) * 4 + (uidx & 3); qb = uidx >> 2; } \
                else { const int u = bx + i * G; if (u >= 512) break; h = u >> 5; qb = u & 31; } \
                att::attn_dense_body<att::bf16>(Qb + (size_t)(qb * 256) * 2048 + h * 128, Kb + (h >> 2) * 128, Vb + (h >> 2) * 128, U + h * 128, qb * 256, L, (char*)lds_raw); } \
        } break;
namespace fk {
#ifndef MIXMASK
#define MIXMASK 63
#endif
#ifndef ONE_LAUNCH
#define ONE_LAUNCH 1
#endif
constexpr int NPH = 22;

__global__ void __launch_bounds__(NWAVES * 64, 2) mega(Args a) {
    extern __shared__ __attribute__((aligned(16))) unsigned char lds_raw[];
    LAS unsigned char* lds = (LAS unsigned char*)lds_raw;
    const int tid0 = threadIdx.x;
    const int G = gridDim.x, bx = blockIdx.x;
    const int vcu = (G % 8 == 0) ? (bx % 8) * (G / 8) + bx / 8 : bx;
    unsigned char* ws = a.ws;
    for (int u = tid0; u < (LDS_BYTES - LDSCTL_OFF) / 4; u += NWAVES * 64) ((LAS unsigned*)(lds + LDSCTL_OFF))[u] = 0u;
    __syncthreads();
    volatile LAS unsigned* MISC = (volatile LAS unsigned*)(lds + MISC_OFF);
    unsigned* barw = (unsigned*)(ws + WS_CTL) + CW_BAR + a.bar_region * XCD_BAR_WORDS;
    XcdBarrier bar; bar.bar = barw; bar.x = 0; bar.st = nullptr;
    if (a.ph_hi - a.ph_lo > 1) bar = xcd_barrier_post(barw, MISC + 8);
    const int NGW = G * NWAVES;
    bf16* U = (bf16*)(ws + WS_U); float* T = (float*)(ws + WS_T); float* H = a.out;
    if (a.pre) { const int lane = tid0 & 63, gw = vcu * NWAVES + __builtin_amdgcn_readfirstlane(tid0 >> 6); for (int m = gw; m < L; m += NGW) row_op(a.pre_src, nullptr, nullptr, nullptr, a.pre_gain, U, a.pre, (size_t)m, lane); return; }

    for (int ph = a.ph_lo; ph < a.ph_hi; ++ph) {
        const int li = ph >= 12 ? 1 : 0;
        int tid = threadIdx.x; asm volatile("" : "+v"(tid));
        const int lane = tid & 63, wave = __builtin_amdgcn_readfirstlane(tid >> 6), gw = vcu * NWAVES + wave;
        switch (ph) {
        case 0: {
            LAS float* scr = (LAS float*)(lds + RING_OFF + wave * 16384);
            constexpr int IT_GIN = 32 * 193, IT_SQ = 32 * 64, IT_AIN = 32 * 96, IT_UP = 32 * 256, IT_DOWN = 128 * 64, IT_PROJ = 4 * 64;
            constexpr int NITEMS = IT_GIN + IT_SQ + IT_AIN + IT_SQ + 2 * IT_UP + 2 * IT_DOWN + 2 * IT_SQ + 2 * IT_PROJ;
            for (int it = gw; it < NITEMS; it += NGW) {
                int r = it;
                if (r < IT_GIN) { p0_transpose_item(a.in[I_GLA_W_IN], DM, GIN, (bf16*)(ws + WS_W_GLA_IN), scr, r, lane); continue; } r -= IT_GIN;
                if (r < IT_SQ) { p0_transpose_item(a.in[I_GLA_W_OUT], DM, DM, (bf16*)(ws + WS_W_GLA_OUT), scr, r, lane); continue; } r -= IT_SQ;
                if (r < IT_AIN) { p0_transpose_item(a.in[I_ATT_W_IN], DM, AIN, (bf16*)(ws + WS_W_ATT_IN), scr, r, lane); continue; } r -= IT_AIN;
                if (r < IT_SQ) { p0_transpose_item(a.in[I_ATT_W_OUT], DM, DM, (bf16*)(ws + WS_W_ATT_OUT), scr, r, lane); continue; } r -= IT_SQ;
                if (r < 2 * IT_UP) { const int l2 = r / IT_UP; p0_transpose_item(a.in[I_W_UP] + (size_t)l2 * DM * DFF, DM, DFF, (bf16*)(ws + WS_W_UP + l2 * 32 * MiB), scr, r % IT_UP, lane); continue; } r -= 2 * IT_UP;
                if (r < 2 * IT_DOWN) { const int l2 = r / IT_DOWN; p0_transpose_item(a.in[I_W_DOWN] + (size_t)l2 * DFF * DM, DFF, DM, (bf16*)(ws + WS_W_DOWN + l2 * 32 * MiB), scr, r % IT_DOWN, lane); continue; } r -= 2 * IT_DOWN;
                if (r < 2 * IT_SQ) { const int l2 = r / IT_SQ; p0_transpose_item(a.in[I_W_PLE_GATE] + (size_t)l2 * DM * DM, DM, DM, (bf16*)(ws + WS_W_GATE + l2 * 8 * MiB), scr, r % IT_SQ, lane); continue; } r -= 2 * IT_SQ;
                { const int l2 = r / IT_PROJ; p0_transpose_item(a.in[I_W_PLE_PROJ] + (size_t)l2 * PLED * DM, PLED, DM, (bf16*)(ws + WS_W_PROJ + l2 * 1 * MiB), scr, r % IT_PROJ, lane); }
            }
            { const float* p = a.in[I_P]; bf16* pb = (bf16*)(ws + WS_PBF);
              for (size_t i = (size_t)vcu * 512 + tid; i < (size_t)2 * L * PLED / 8; i += (size_t)G * 512) {
                  const f32x4 x0 = *(const GAS f32x4*)(p + i * 8), x1 = *(const GAS f32x4*)(p + i * 8 + 4);
                  v4u o; o.x = pk2(x0.x, x0.y); o.y = pk2(x0.z, x0.w); o.z = pk2(x1.x, x1.y); o.w = pk2(x1.z, x1.w); *(GAS v4u*)(pb + i * 8) = o; } }
            for (int e = vcu * 512 + tid; e < 128 * 32; e += G * 512) { const int pos = e >> 5, j = e & 31; const float ang = (float)pos * exp2f(-(float)j * (13.287712379549449f / 32.f));
                float sn, cs; sincosf(ang, &sn, &cs); ((float2*)(ws + WS_ROPE))[e] = make_float2(cs, sn); }
            for (int m = gw; m < L; m += NGW) row_op(a.in[I_X], nullptr, nullptr, nullptr, a.in[I_G_PRE_MIX], U, 1, (size_t)m, lane);
        } break;
        case 5: case 15: {
            pg8::Gemm g{U, (const bf16*)(ws + (li ? WS_W_ATT_OUT : WS_W_GLA_OUT)), L, DM, DM}; pg8::StaticOrder S; S.init(L, DM, G, bx);
            pg8::EpiF32 E{T, DM};
            pg8::gemm_phase<pg8::EpiF32, pg8::StaticOrder, true, true>(lds + RING_OFF, g, S, E);
        } break;
        case 6: case 16: {
            const float* hin = li ? H : a.in[I_X];
            for (int m = gw; m < L; m += NGW) row_op(hin, T, a.in[I_G_POST_MIX] + li * DM, H, a.in[I_G_PRE_MLP] + li * DM, U, 1, (size_t)m, lane);
        } break;
        case 7: case 17: {
            pg8::Gemm g{U, (const bf16*)(ws + WS_W_UP + li * 32 * MiB), L, DFF, DM}; pg8::StaticOrder S; S.init(L, DFF, G, bx);
            pg8::EpiB16<2> E{(bf16*)(ws + WS_HID), DFF, 0, 0};
            pg8::gemm_phase<pg8::EpiB16<2>, pg8::StaticOrder, true, true>(lds + RING_OFF, g, S, E);
        } break;
        case 8: case 18: {
            pg8::Gemm g{(const bf16*)(ws + WS_HID), (const bf16*)(ws + WS_W_DOWN + li * 32 * MiB), L, DM, DFF}; pg8::StaticOrder S; S.init(L, DM, G, bx);
            pg8::EpiF32 E{T, DM};
            pg8::gemm_phase<pg8::EpiF32, pg8::StaticOrder, true, true>(lds + RING_OFF, g, S, E);
        } break;
        case 9: case 19: {
            for (int m = gw; m < L; m += NGW) row_op(H, T, a.in[I_G_POST_MLP] + li * DM, H, nullptr, U, 2, (size_t)m, lane);
        } break;
        case 10: case 20: {
            float* Eb = (float*)(ws + WS_E);
            { pg8::Gemm g{(const bf16*)(ws + WS_PBF + li * 4 * MiB), (const bf16*)(ws + WS_W_PROJ + li * 1 * MiB), L, DM, PLED}; pg8::StaticOrder S; S.init(L, DM, G, bx);
              pg8::EpiF32 E{Eb, DM};
              pg8::gemm_phase<pg8::EpiF32, pg8::StaticOrder, true, true>(lds + RING_OFF, g, S, E); }
            { pg8::Gemm g{U, (const bf16*)(ws + WS_W_GATE + li * 8 * MiB), L, DM, DM}; pg8::StaticOrder S; S.init(L, DM, G, bx);
              pg8::EpiGate E{Eb, T, DM};
              pg8::gemm_phase<pg8::EpiGate, pg8::StaticOrder, true, true>(lds + RING_OFF, g, S, E); }
        } break;
        case 11: case 21: {
            for (int m = gw; m < L; m += NGW) row_op(H, T, a.in[I_G_PLE] + li * DM, H, a.in[I_G_PRE_MIX] + DM, U, li ? 0 : 1, (size_t)m, lane);
        } break;
        FK_ATTN_PHASES
        FK_GLA_PHASES
        default: break;
        }
        if (ph + 1 < a.ph_hi) xcd_barrier(bar);
    }
}

static int g_bar_region = 0;
static void launch_mega(hipStream_t st, int grid, Args& a, int lo, int hi, int pre, const float* pre_src, const float* pre_gain) {
    a.ph_lo = lo; a.ph_hi = hi; a.pre = pre; if (hi - lo > 1) a.bar_region = g_bar_region++; a.pre_src = pre_src; a.pre_gain = pre_gain;
    hipLaunchKernelGGL(mega, dim3(grid), dim3(NWAVES * 64), LDS_BYTES, st, a);
    const hipError_t le = hipPeekAtLastError();
    if (le != hipSuccess) fprintf(stderr, "kernel_launch: launch [%d,%d) failed: %s\n", lo, hi, hipGetErrorName(le));
}
static void run_phases(hipStream_t st, int grid, Args& a, int lo, int hi) {
    if (ONE_LAUNCH) launch_mega(st, grid, a, lo, hi, 0, nullptr, nullptr);
    else for (int p = lo; p < hi; ++p) launch_mega(st, grid, a, p, p + 1, 0, nullptr, nullptr);
}
}

extern "C" void kernel_launch(void* const* d_in, const int* in_sizes, int n_in, void* d_out, int out_size, void* d_ws, size_t ws_size, hipStream_t stream) {
    using namespace fk;
    static int grid = 0;
    if (grid == 0) {
        if (n_in != 22 || in_sizes[0] != L * DM || out_size != L * DM || ws_size < WS_END) { fprintf(stderr, "kernel_launch: unexpected shapes n_in %d out %d ws %zu (need >= %zu)\n", n_in, out_size, ws_size, (size_t)WS_END); grid = -1; return; }
        int dev = 0, cus = 0, per_cu = 0;
        if (hipGetDevice(&dev) != hipSuccess || hipDeviceGetAttribute(&cus, hipDeviceAttributeMultiprocessorCount, dev) != hipSuccess) { grid = -1; return; }
        if (hipFuncSetAttribute((const void*)mega, hipFuncAttributeMaxDynamicSharedMemorySize, LDS_BYTES) != hipSuccess) { fprintf(stderr, "kernel_launch: hipFuncSetAttribute failed\n"); grid = -1; return; }
        if (hipOccupancyMaxActiveBlocksPerMultiprocessor(&per_cu, (const void*)mega, NWAVES * 64, LDS_BYTES) != hipSuccess || per_cu < 1) { fprintf(stderr, "kernel_launch: occupancy query says %d blocks per CU\n", per_cu); per_cu = 1; }
        (void)hipGetLastError();
        grid = cus;
        if (grid != 256) fprintf(stderr, "kernel_launch: note: %d CUs\n", grid);
    }
    if (grid < 0) return;
    hipMemsetAsync((char*)d_ws + WS_CTL, 0, CTL_ZERO_BYTES, stream);
    g_bar_region = 0;
    Args a{};
    for (int i = 0; i < 22; ++i) a.in[i] = (const float*)d_in[i];
    a.out = (float*)d_out; a.ws = (unsigned char*)d_ws;
    float* h = (float*)d_out;
#if MIXMASK == 63 && ONE_LAUNCH
    launch_mega(stream, grid, a, 0, NPH, 0, nullptr, nullptr);
#else
    nv::In I; { const float** ip = (const float**)&I; for (int i = 0; i < 22; ++i) ip[i] = (const float*)d_in[i]; }
    char* scr = (char*)d_ws + (size_t)210 * MiB;
    if (MIXMASK) launch_mega(stream, grid, a, 0, 1, 0, nullptr, nullptr);
    const int lo[6] = {1, 7, 10, 12, 17, 20}, hi[6] = {7, 10, 12, 17, 20, 22};
    for (int s = 0; s < 6; ++s) {
        const int li = s / 3;
        if ((MIXMASK >> s) & 1) {
            const float* src = (s == 0) ? I.x : h;
            if (s == 0) launch_mega(stream, grid, a, 0, 0, 1, src, I.g_pre_mix);
            else if (s == 3) launch_mega(stream, grid, a, 0, 0, 1, src, I.g_pre_mix + DM);
            else if (s == 1 || s == 4) launch_mega(stream, grid, a, 0, 0, 1, src, I.g_pre_mlp + li * DM);
            else launch_mega(stream, grid, a, 0, 0, 2, src, nullptr);
            run_phases(stream, grid, a, lo[s], hi[s]);
        } else {
            if (s == 0) nv::mixer_gla(stream, I, I.x, h, scr);
            else if (s == 3) nv::mixer_attn(stream, I, h, h, scr);
            else if (s == 1 || s == 4) nv::mlp(stream, I, li, h, h, scr);
            else nv::ple(stream, I, li, h, h, scr);
        }
    }
#endif
}
```
